# Optimizing an MI355X kernel written in HIP

```python
import jax, jax.numpy as jnp
from jax import lax
import numpy as np

D_MODEL = 2048
BATCH = 2
SEQ = 16384
DEPTH = 1

D_MIX = D_MODEL
D_RWKV = D_MIX // 2
D_RET = D_MIX - D_RWKV
RWKV_HEAD = 64
RWKV_HEADS = D_RWKV // RWKV_HEAD
RET_HEADS = 4
RET_HEAD = D_RET // RET_HEADS
RET_CHUNK = 128
LORA_DECAY = 64
LORA_A = 64
LORA_GATE = 128
D_FF = 4 * D_MODEL
ROPE_BASE = 10000.0
LN_EPS = 1e-5
RWKV_GN_EPS = 64e-5
RET_GN_EPS = 1e-6
ALPHA = (2.0 * DEPTH) ** 0.25
BETA = (8.0 * DEPTH) ** -0.25

RWKV_SHIFT_WIDTH = 3 * D_RWKV + LORA_DECAY + LORA_A + LORA_GATE
N_IN = RWKV_SHIFT_WIDTH + 4 * D_RET
RWKV_SPLITS = (D_RWKV, 2 * D_RWKV, 3 * D_RWKV, 3 * D_RWKV + LORA_DECAY,
               3 * D_RWKV + LORA_DECAY + LORA_A)
RET_SPLITS = (D_RET, 2 * D_RET, 3 * D_RET)

kernel_name = "hymba_rwkv7_retnet_deepnorm"


def _layer_norm(x, w, b):
    xf = x.astype(jnp.float32)
    mu = xf.mean(-1, keepdims=True)
    var = jnp.square(xf - mu).mean(-1, keepdims=True)
    return ((xf - mu) * lax.rsqrt(var + LN_EPS) * w + b).astype(x.dtype)


def _head_norm(y, eps):
    mu = y.mean(-1, keepdims=True)
    var = jnp.square(y - mu).mean(-1, keepdims=True)
    return (y - mu) * lax.rsqrt(var + eps)


def _token_shift(f, mu):
    prev = jnp.pad(f, ((0, 0), (1, 0), (0, 0)))[:, :-1]
    return f + (prev - f) * mu


def _wkv7_scan(r, decay, k, v, a_vec, b_vec):
    B, T, H, N = r.shape

    def step(S, inp):
        r_t, w_t, k_t, v_t, a_t, b_t = inp
        sa = jnp.einsum('bhvk,bhk->bhv', S, a_t)
        S = (S * w_t[:, :, None, :] + sa[..., None] * b_t[:, :, None, :]
             + v_t[..., None] * k_t[:, :, None, :])
        y_t = jnp.einsum('bhvk,bhk->bhv', S, r_t)
        return S, y_t

    xs = tuple(jnp.moveaxis(t, 1, 0) for t in (r, decay, k, v, a_vec, b_vec))
    S0 = jnp.zeros((B, H, N, N), jnp.float32)
    _, y = lax.scan(step, S0, xs)
    return jnp.moveaxis(y, 0, 1)


def _rwkv7_mix(feat, mu_shift, w0, w_lora_up, a0, a_lora_up, g_lora_up,
               k_k, k_a, r_k, gn_w, gn_b):
    B, T, _ = feat.shape
    f = _token_shift(feat.astype(jnp.float32), mu_shift)
    r, k, v, lw, la, lg = jnp.split(f, RWKV_SPLITS, axis=-1)
    w = -jax.nn.softplus(-(w0 + jnp.tanh(lw) @ w_lora_up)) - 0.5
    a = jax.nn.sigmoid(a0 + la @ a_lora_up)
    g = jax.nn.sigmoid(lg) @ g_lora_up

    def heads(t):
        return t.reshape(B, T, RWKV_HEADS, RWKV_HEAD)

    kk = heads(k * k_k)
    kk = kk / jnp.maximum(jnp.sqrt(jnp.sum(kk * kk, -1, keepdims=True)), 1e-12)
    k = k * (1.0 + (a - 1.0) * k_a)
    r, k, v, a = heads(r), heads(k), heads(v), heads(a)
    decay = jnp.exp(-jnp.exp(heads(w)))
    y = _wkv7_scan(r, decay, k, v, -kk, kk * a)
    y = _head_norm(y, RWKV_GN_EPS) * gn_w.reshape(RWKV_HEADS, RWKV_HEAD) \
        + gn_b.reshape(RWKV_HEADS, RWKV_HEAD)
    bonus = jnp.sum(r * k * r_k, -1, keepdims=True) * v
    return (y + bonus).reshape(B, T, D_RWKV) * g


def _rotary(t, cos, sin):
    t1, t2 = t[..., 0::2], t[..., 1::2]
    return jnp.stack([t1 * cos - t2 * sin, t1 * sin + t2 * cos], axis=-1).reshape(t.shape)


def _retention_mix(q, k, v, g, gn_w):
    B, T, _ = q.shape
    nC = T // RET_CHUNK

    def heads(t):
        return t.astype(jnp.float32).reshape(B, T, RET_HEADS, RET_HEAD).transpose(0, 2, 1, 3)

    q, k, v = heads(q), heads(k), heads(v)
    pos = jnp.arange(T, dtype=jnp.float32)
    inv_freq = 1.0 / (ROPE_BASE ** jnp.linspace(0.0, 1.0, RET_HEAD // 2, dtype=jnp.float32))
    theta = pos[:, None] * inv_freq[None, :]
    cos, sin = jnp.cos(theta), jnp.sin(theta)
    q = _rotary(q, cos, sin)
    k = _rotary(k, cos, sin) * RET_HEAD ** -0.5

    log_gamma = jnp.log(1.0 - 2.0 ** (-5.0 - jnp.arange(RET_HEADS, dtype=jnp.float32)))
    idx = jnp.arange(RET_CHUNK, dtype=jnp.float32)
    rel = idx[:, None] - idx[None, :]
    decay_mask = jnp.where(rel >= 0,
                           jnp.exp(jnp.maximum(rel, 0.0) * log_gamma[:, None, None]), 0.0)
    q_decay = jnp.exp((idx + 1.0) * log_gamma[:, None])
    k_decay = jnp.exp((RET_CHUNK - 1.0 - idx) * log_gamma[:, None])
    chunk_decay = jnp.exp(RET_CHUNK * log_gamma)

    def chunks(t):
        return t.reshape(B, RET_HEADS, nC, RET_CHUNK, RET_HEAD)

    qc, kc, vc = chunks(q), chunks(k), chunks(v)
    scores = jnp.einsum('bhncd,bhnmd->bhncm', qc, kc) * decay_mask[:, None]
    intra = jnp.einsum('bhncm,bhnme->bhnce', scores, vc)

    def step(R, inp):
        q_n, k_n, v_n = inp
        cross = jnp.einsum('bhcd,bhde->bhce', q_n, R) * q_decay[None, :, :, None]
        R = R * chunk_decay[None, :, None, None] + jnp.einsum(
            'bhcd,bhce->bhde', k_n * k_decay[None, :, :, None], v_n)
        return R, cross

    xs = (jnp.moveaxis(qc, 2, 0), jnp.moveaxis(kc, 2, 0), jnp.moveaxis(vc, 2, 0))
    R0 = jnp.zeros((B, RET_HEADS, RET_HEAD, RET_HEAD), jnp.float32)
    _, cross = lax.scan(step, R0, xs)
    y = intra + jnp.moveaxis(cross, 0, 2)
    y = y.reshape(B, RET_HEADS, T, RET_HEAD).transpose(0, 2, 1, 3)
    y = _head_norm(y, RET_GN_EPS) * gn_w.reshape(RET_HEADS, RET_HEAD)
    return y.reshape(B, T, D_RET) * jax.nn.silu(g.astype(jnp.float32))


def _hybrid_layer(x, w_in, mu_shift, w0, w_lora_up, a0, a_lora_up, g_lora_up,
                  k_k, k_a, r_k, rwkv_gn_w, rwkv_gn_b, ret_gn_w, w_o,
                  ln1_w, ln1_b, w_up, w_down, ln2_w, ln2_b):
    h = x @ w_in
    y_a = _rwkv7_mix(h[..., :RWKV_SHIFT_WIDTH], mu_shift, w0, w_lora_up, a0,
                     a_lora_up, g_lora_up, k_k, k_a, r_k, rwkv_gn_w, rwkv_gn_b)
    q, k, v, g = jnp.split(h[..., RWKV_SHIFT_WIDTH:], RET_SPLITS, axis=-1)
    y_b = _retention_mix(q, k, v, g, ret_gn_w)
    mix = jnp.concatenate([y_a, y_b], axis=-1).astype(x.dtype) @ w_o
    x = _layer_norm(ALPHA * x + mix, ln1_w, ln1_b)
    ff = jnp.square(jax.nn.relu(x @ w_up)) @ w_down
    return _layer_norm(ALPHA * x + ff, ln2_w, ln2_b)


def setup_inputs(seed: int = 0) -> dict:
    key = jax.random.key(seed)
    ks = jax.random.split(key, 24)
    f32 = jnp.float32

    def nrm(k, shape, scale):
        return jax.random.normal(k, shape, f32) * scale

    L = DEPTH
    col_scale = jnp.concatenate([
        jnp.ones((2 * D_RWKV,), f32), jnp.full((D_RWKV,), BETA, f32),
        jnp.ones((LORA_DECAY + LORA_A + LORA_GATE + 2 * D_RET,), f32),
        jnp.full((D_RET,), BETA, f32), jnp.ones((D_RET,), f32)])
    ratio = jnp.arange(D_RWKV, dtype=f32) / (D_RWKV - 1)
    return {
        "x": nrm(ks[0], (BATCH, SEQ, D_MODEL), 1.0),
        "w_in": nrm(ks[1], (L, D_MODEL, N_IN), D_MODEL ** -0.5) * col_scale,
        "mu_shift": jax.random.uniform(ks[2], (L, RWKV_SHIFT_WIDTH), f32, 0.1, 0.9),
        "w0": jnp.broadcast_to(-6.5 + 5.0 * ratio ** 0.85, (L, D_RWKV)) + nrm(ks[3], (L, D_RWKV), 0.01),
        "w_lora_up": nrm(ks[4], (L, LORA_DECAY, D_RWKV), 0.1 * LORA_DECAY ** -0.5),
        "a0": nrm(ks[5], (L, D_RWKV), 0.01),
        "a_lora_up": nrm(ks[6], (L, LORA_A, D_RWKV), 0.5 * LORA_A ** -0.5),
        "g_lora_up": nrm(ks[7], (L, LORA_GATE, D_RWKV), LORA_GATE ** -0.5),
        "k_k": 0.85 + nrm(ks[8], (L, D_RWKV), 0.02),
        "k_a": 1.0 + nrm(ks[9], (L, D_RWKV), 0.02),
        "r_k": nrm(ks[10], (L, RWKV_HEADS, RWKV_HEAD), 0.1),
        "rwkv_gn_w": 1.0 + nrm(ks[11], (L, D_RWKV), 0.02),
        "rwkv_gn_b": nrm(ks[12], (L, D_RWKV), 0.02),
        "ret_gn_w": 1.0 + nrm(ks[13], (L, D_RET), 0.02),
        "w_o": nrm(ks[14], (L, D_MIX, D_MODEL), BETA * D_MIX ** -0.5),
        "ln1_w": 1.0 + nrm(ks[15], (L, D_MODEL), 0.02),
        "ln1_b": nrm(ks[16], (L, D_MODEL), 0.02),
        "w_up": nrm(ks[17], (L, D_MODEL, D_FF), BETA * D_MODEL ** -0.5),
        "w_down": nrm(ks[18], (L, D_FF, D_MODEL), BETA * D_FF ** -0.5),
        "ln2_w": 1.0 + nrm(ks[19], (L, D_MODEL), 0.02),
        "ln2_b": nrm(ks[20], (L, D_MODEL), 0.02),
    }


def reference(x, w_in, mu_shift, w0, w_lora_up, a0, a_lora_up, g_lora_up,
              k_k, k_a, r_k, rwkv_gn_w, rwkv_gn_b, ret_gn_w, w_o,
              ln1_w, ln1_b, w_up, w_down, ln2_w, ln2_b):
    for l in range(DEPTH):
        x = _hybrid_layer(x, w_in[l], mu_shift[l], w0[l], w_lora_up[l], a0[l],
                          a_lora_up[l], g_lora_up[l], k_k[l], k_a[l], r_k[l],
                          rwkv_gn_w[l], rwkv_gn_b[l], ret_gn_w[l], w_o[l],
                          ln1_w[l], ln1_b[l], w_up[l], w_down[l], ln2_w[l], ln2_b[l])
    return x
```

```cpp
#include <hip/hip_runtime.h>
#include <hip/hip_cooperative_groups.h>
#include <cstdio>
#include <cstdint>
namespace cg = cooperative_groups;
namespace pg8 {
#define PG8_LAS __attribute__((address_space(3)))
typedef unsigned short bf16_t;
typedef short bf16x8 __attribute__((ext_vector_type(8)));
typedef float f32x4 __attribute__((ext_vector_type(4)));
typedef unsigned u32x4 __attribute__((ext_vector_type(4)));
constexpr int BM = 256, BK = 64, HALF = 128, HTB = HALF * BK * 2  , STAGE_BYTES = 8 * HTB, NXCD = 8, WGM = 8;

__host__ __device__ __forceinline__ int lds_byte(int r, int c) { const int st = (r >> 4) * 2 + (c >> 5), rr = r & 15, cc = c & 31, ob = rr * 64 + cc * 2; return st * 1024 + (ob ^ (((ob >> 9) & 1) << 5)); }
__host__ __device__ __forceinline__ void stage_rc(int b, int& R, int& C) { const int st = b / 1024, sb = b % 1024, swz = sb ^ (((sb >> 9) & 1) << 5); R = (st >> 1) * 16 + swz / 64; C = (st & 1) * 32 + (swz % 64) / 2; }
__host__ __device__ __forceinline__ int perm32(int rho) { const int n = rho >> 4, i = rho & 15; return 8 * (i >> 2) + 4 * n + (i & 3); }

struct Unit { int pm, pn; };
struct Gemm { const bf16_t* A; const bf16_t* Bt; int M, N, K; };

struct StaticOrder {
    int nM, nN, nwg, G, c;
    __host__ __device__ void init(int M, int N, int G_, int c_) { nM = M / BM; nN = N / BM; nwg = nM * nN; G = G_; c = c_; }
    __host__ __device__ bool next(int i, Unit& u) const {
        const long L = (long)i * G + c; if (L >= nwg) return false;
        int wgid = (int)L; { const int q = nwg / NXCD, r = nwg % NXCD, xcd = wgid % NXCD, off = wgid / NXCD; wgid = (xcd < r ? xcd * (q + 1) : r * (q + 1) + (xcd - r) * q) + off; }
        const int nig = WGM * nN, gid = wgid / nig, fm = gid * WGM, gsz = (nM - fm) < WGM ? (nM - fm) : WGM;
        u.pm = fm + ((wgid % nig) % gsz); u.pn = (wgid % nig) / gsz; return true;
    }
    __device__ __forceinline__ void a_ready(const Unit&) const {}
    __device__ __forceinline__ void done(const Unit&) const {}
};

__device__ __forceinline__ unsigned cvt_pk_bf16(float lo, float hi) { unsigned r; asm volatile("v_cvt_pk_bf16_f32 %0, %1, %2" : "=v"(r) : "v"(lo), "v"(hi)); return r; }
typedef _Float16 f16x2_t __attribute__((ext_vector_type(2)));
__device__ __forceinline__ unsigned cvt_pk_f16(float lo, float hi) { f16x2_t v; v.x = (_Float16)lo; v.y = (_Float16)hi; return __builtin_bit_cast(unsigned, v); }
template <int MODE> struct EpiH16 {
    static constexpr bool PERM = true, AFTER_DRAIN = false;
    bf16_t* O0; bf16_t* O1; bf16_t* O2; int ld0, ld1, ld2, split0, split1;
    __device__ __forceinline__ void operator()(const f32x4 (&acc)[2][2][4][2], const Unit& u, int wr, int wc, int fr, int fq) const {
        const int row0 = u.pm * BM + wr * 64 + fr; int colt = u.pn * BM; bf16_t* base = O0; int ldc = ld0;
        if (colt >= split1) { base = O2; ldc = ld2; colt -= split1; } else if (colt >= split0) { base = O1; ldc = ld1; colt -= split0; }
        const int col0 = colt + wc * 32 + 8 * fq;
#pragma unroll
        for (int ai = 0; ai < 2; ++ai)
#pragma unroll
            for (int m = 0; m < 4; ++m) { bf16_t* rowp = base + (size_t)(row0 + ai * HALF + m * 16) * ldc + col0;
#pragma unroll
                for (int bj = 0; bj < 2; ++bj) { f32x4 v0 = acc[ai][bj][m][0], v1 = acc[ai][bj][m][1];
                    if (MODE == 1) {
#pragma unroll
                        for (int e = 0; e < 4; ++e) { float a = fmaxf(v0[e], 0.f), b = fmaxf(v1[e], 0.f); v0[e] = a * a; v1[e] = b * b; } }
                    u32x4 w;
                    if (MODE == 2) { w.x = cvt_pk_f16(v0[0], v0[1]); w.y = cvt_pk_f16(v0[2], v0[3]); w.z = cvt_pk_f16(v1[0], v1[1]); w.w = cvt_pk_f16(v1[2], v1[3]); }
                    else { w.x = cvt_pk_bf16(v0[0], v0[1]); w.y = cvt_pk_bf16(v0[2], v0[3]); w.z = cvt_pk_bf16(v1[0], v1[1]); w.w = cvt_pk_bf16(v1[2], v1[3]); }
                    *(u32x4*)(rowp + bj * HALF) = w; } }
    }
};
struct EpiResid {
    static constexpr bool PERM = false, AFTER_DRAIN = false;
    const float* base; float* out; int ldc; float alpha;
    __device__ __forceinline__ void operator()(const f32x4 (&acc)[2][2][4][2], const Unit& u, int wr, int wc, int fr, int fq) const {
        const int row0 = u.pm * BM + wr * 64 + fr, col0 = u.pn * BM + wc * 32 + 4 * fq;
#pragma unroll
        for (int ai = 0; ai < 2; ++ai)
#pragma unroll
            for (int m = 0; m < 4; ++m) { const size_t off = (size_t)(row0 + ai * HALF + m * 16) * ldc + col0;
#pragma unroll
                for (int bj = 0; bj < 2; ++bj)
#pragma unroll
                    for (int n = 0; n < 2; ++n) { const size_t p = off + bj * HALF + n * 16; const f32x4 b = *(const f32x4*)(base + p); *(f32x4*)(out + p) = b * alpha + acc[ai][bj][m][n]; } }
    }
};
template <class Epi, class Sched, bool ALIGN_EPI = false, bool SP2 = false>
__device__ __forceinline__ void gemm_phase(PG8_LAS unsigned char* lds, const Gemm g, const Sched& S, const Epi& E) {
    const int tid = threadIdx.x, wid = __builtin_amdgcn_readfirstlane(tid >> 6), lane = tid & 63, wr = wid >> 2, wc = wid & 3, fr = lane & 15, fq = lane >> 4;
    const int K = g.K, nt = K / BK;
    unsigned voffA[2], voffB[2];
#pragma unroll
    for (int i = 0; i < 2; ++i) { int R, C; stage_rc(tid * 16 + i * 8192, R, C); const int Rb = Epi::PERM ? ((R & ~31) + perm32(R & 31)) : R;
        voffA[i] = (unsigned)(R * K + C) * 2u; voffB[i] = (unsigned)(Rb * K + C) * 2u; }
    const size_t kstep = (size_t)(BK * 2);
    const size_t hstep = (size_t)HALF * K * 2;
    const size_t tstep = 2 * hstep;
    const unsigned ldsw = (unsigned)wid * 1024u;
    const int aoff = lds_byte(wr * 64 + fr, fq * 8), boff = lds_byte(wc * 32 + fr, fq * 8);
#define PG8_SA(b, h) (((b) * 2 + (h)) * HTB)
#define PG8_SB(b, h) ((4 + (b) * 2 + (h)) * HTB)
#define PG8_STAGE(bufoff, gbase, voff) do { _Pragma("unroll") for (int _i = 0; _i < 2; ++_i) \
        __builtin_amdgcn_global_load_lds((const unsigned*)((const char*)(gbase) + (voff)[_i]), (PG8_LAS unsigned*)(lds + (bufoff) + ldsw + _i * 8192), 16, 0, 0); } while (0)
#define PG8_LDA(dst, b, h) do { _Pragma("unroll") for (int m = 0; m < 4; ++m) _Pragma("unroll") for (int k = 0; k < 2; ++k) dst[m][k] = *(const PG8_LAS bf16x8*)(lds + PG8_SA(b, h) + aoff + m * 2048 + k * 1024); } while (0)
#define PG8_LDB(dst, b, h) do { _Pragma("unroll") for (int n = 0; n < 2; ++n) _Pragma("unroll") for (int k = 0; k < 2; ++k) dst[n][k] = *(const PG8_LAS bf16x8*)(lds + PG8_SB(b, h) + boff + n * 2048 + k * 1024); } while (0)
#define PG8_MMA(ai, bj, At, Bt) do { __builtin_amdgcn_s_setprio(1); _Pragma("unroll") for (int m = 0; m < 4; ++m) _Pragma("unroll") for (int n = 0; n < 2; ++n) _Pragma("unroll") for (int k = 0; k < 2; ++k) \
        acc[ai][bj][m][n] = __builtin_amdgcn_mfma_f32_16x16x32_bf16(Bt[n][k], At[m][k], acc[ai][bj][m][n], 0, 0, 0); __builtin_amdgcn_s_setprio(0); } while (0)
#define PG8_WAIT_V(n) asm volatile("s_waitcnt vmcnt(" #n ")" ::: "memory")
#define PG8_WAIT_L(n) asm volatile("s_waitcnt lgkmcnt(" #n ")" ::: "memory")
#define PG8_BAR __builtin_amdgcn_s_barrier()
#define PG8_SCHED __builtin_amdgcn_sched_barrier(0)
    Unit cur, nxt; int ui = 0;
    if (!S.next(0, cur)) return;
    f32x4 acc[2][2][4][2];
#pragma unroll
    for (int a = 0; a < 2; ++a)
#pragma unroll
        for (int b = 0; b < 2; ++b)
#pragma unroll
            for (int m = 0; m < 4; ++m)
#pragma unroll
                for (int n = 0; n < 2; ++n) acc[a][b][m][n] = (f32x4){0.f, 0.f, 0.f, 0.f};
    bf16x8 At[4][2], B0[2][2], B1[2][2];
    const char* cA = (const char*)g.A + (size_t)cur.pm * tstep; const char* cB = (const char*)g.Bt + (size_t)cur.pn * tstep;
    S.a_ready(cur);
    if constexpr (SP2) {
        PG8_STAGE(PG8_SB(0, 0), cB, voffB); PG8_STAGE(PG8_SB(0, 1), cB + hstep, voffB); PG8_STAGE(PG8_SA(0, 0), cA, voffA); PG8_STAGE(PG8_SA(0, 1), cA + hstep, voffA);
        if (wr == 1) PG8_BAR;
        PG8_WAIT_V(2); PG8_BAR;
        PG8_STAGE(PG8_SB(1, 0), cB + kstep, voffB); PG8_STAGE(PG8_SA(1, 0), cA + kstep, voffA); PG8_STAGE(PG8_SB(1, 1), cB + hstep + kstep, voffB);
        PG8_WAIT_V(6); PG8_BAR;
    } else {
        PG8_STAGE(PG8_SB(0, 0), cB, voffB); PG8_STAGE(PG8_SA(0, 0), cA, voffA); PG8_STAGE(PG8_SB(0, 1), cB + hstep, voffB); PG8_STAGE(PG8_SA(0, 1), cA + hstep, voffA);
        if (wr == 1) PG8_BAR;
        PG8_WAIT_V(4); PG8_BAR;
        PG8_STAGE(PG8_SB(1, 0), cB + kstep, voffB); PG8_STAGE(PG8_SA(1, 0), cA + kstep, voffA); PG8_STAGE(PG8_SB(1, 1), cB + hstep + kstep, voffB);
        PG8_WAIT_V(6); PG8_BAR;
    }
    for (;;) {
        const bool has_next = S.next(ui + 1, nxt);
        const char* nA = has_next ? (const char*)g.A + (size_t)nxt.pm * tstep : cA; const char* nB = has_next ? (const char*)g.Bt + (size_t)nxt.pn * tstep : cB;
        for (int t = 0; t < nt; t += 2) {
            const bool last = (t == nt - 2);
            const char* a1 = cA + (size_t)(t + 1) * kstep;
            const char* a2 = last ? nA : cA + (size_t)(t + 2) * kstep; const char* b2 = last ? nB : cB + (size_t)(t + 2) * kstep;
            const char* a3 = a2 + kstep; const char* b3 = b2 + kstep;
            if (last && has_next) S.a_ready(nxt);
            if constexpr (SP2) {
            PG8_LDB(B0, 0, 0); PG8_LDB(B1, 0, 1); PG8_SCHED; PG8_LDA(At, 0, 0); PG8_STAGE(PG8_SA(1, 1), a1 + hstep, voffA);
            PG8_WAIT_V(8); PG8_WAIT_L(0); PG8_BAR; PG8_MMA(0, 0, At, B0); PG8_MMA(0, 1, At, B1); PG8_BAR; PG8_SCHED;
            PG8_LDA(At, 0, 1); PG8_STAGE(PG8_SB(0, 0), b2, voffB); PG8_STAGE(PG8_SB(0, 1), b2 + hstep, voffB); PG8_STAGE(PG8_SA(0, 0), a2, voffA);
            PG8_WAIT_V(8); PG8_WAIT_L(0); PG8_BAR; PG8_MMA(1, 0, At, B0); PG8_MMA(1, 1, At, B1); PG8_BAR; PG8_SCHED;
            PG8_LDB(B0, 1, 0); PG8_LDB(B1, 1, 1); PG8_SCHED; PG8_LDA(At, 1, 0); PG8_STAGE(PG8_SA(0, 1), a2 + hstep, voffA);
            PG8_WAIT_V(8); PG8_WAIT_L(0); PG8_BAR; PG8_MMA(0, 0, At, B0); PG8_MMA(0, 1, At, B1); PG8_BAR; PG8_SCHED;
            PG8_LDA(At, 1, 1); PG8_STAGE(PG8_SB(1, 0), b3, voffB); PG8_STAGE(PG8_SB(1, 1), b3 + hstep, voffB); PG8_STAGE(PG8_SA(1, 0), a3, voffA);
            PG8_WAIT_V(8); PG8_WAIT_L(0); PG8_BAR; PG8_MMA(1, 0, At, B0); PG8_MMA(1, 1, At, B1); PG8_BAR; PG8_SCHED;
            } else {
            PG8_LDB(B0, 0, 0); PG8_SCHED; PG8_LDA(At, 0, 0); PG8_STAGE(PG8_SA(1, 1), a1 + hstep, voffA);
            PG8_WAIT_L(8); PG8_BAR; PG8_WAIT_L(0); PG8_MMA(0, 0, At, B0); PG8_BAR; PG8_SCHED;
            PG8_LDB(B1, 0, 1); PG8_STAGE(PG8_SB(0, 0), b2, voffB);
            PG8_BAR; PG8_WAIT_L(0); PG8_MMA(0, 1, At, B1); PG8_BAR;
            PG8_LDA(At, 0, 1); PG8_STAGE(PG8_SA(0, 0), a2, voffA);
            PG8_BAR; PG8_WAIT_L(0); PG8_MMA(1, 0, At, B0); PG8_BAR; PG8_SCHED;
            PG8_STAGE(PG8_SB(0, 1), b2 + hstep, voffB);
            PG8_WAIT_V(6); PG8_BAR; PG8_MMA(1, 1, At, B1); PG8_BAR;
            PG8_LDB(B0, 1, 0); PG8_SCHED; PG8_LDA(At, 1, 0); PG8_STAGE(PG8_SA(0, 1), a2 + hstep, voffA);
            PG8_WAIT_L(8); PG8_BAR; PG8_WAIT_L(0); PG8_MMA(0, 0, At, B0); PG8_BAR; PG8_SCHED;
            PG8_LDB(B1, 1, 1); PG8_STAGE(PG8_SB(1, 0), b3, voffB);
            PG8_BAR; PG8_WAIT_L(0); PG8_MMA(0, 1, At, B1); PG8_BAR;
            PG8_LDA(At, 1, 1); PG8_STAGE(PG8_SA(1, 0), a3, voffA);
            PG8_BAR; PG8_WAIT_L(0); PG8_MMA(1, 0, At, B0); PG8_BAR; PG8_SCHED;
            PG8_STAGE(PG8_SB(1, 1), b3 + hstep, voffB);
            PG8_WAIT_V(6); PG8_BAR; PG8_MMA(1, 1, At, B1); PG8_BAR;
            }
        }
        if constexpr (ALIGN_EPI) { if (wr == 0) PG8_BAR; }
        if constexpr (!Epi::AFTER_DRAIN) { E(acc, cur, wr, wc, fr, fq); S.done(cur); }
        if (!has_next) break;
#pragma unroll
        for (int a = 0; a < 2; ++a)
#pragma unroll
            for (int b = 0; b < 2; ++b)
#pragma unroll
                for (int m = 0; m < 4; ++m)
#pragma unroll
                    for (int n = 0; n < 2; ++n) acc[a][b][m][n] = (f32x4){0.f, 0.f, 0.f, 0.f};
        cur = nxt; cA = nA; cB = nB; ++ui;
        if constexpr (ALIGN_EPI) { if (wr == 1) PG8_BAR; }
    }
    PG8_WAIT_V(0);
    if constexpr (!ALIGN_EPI) { if (wr == 0) PG8_BAR; }
    PG8_BAR;
    if constexpr (Epi::AFTER_DRAIN) { E.fused(acc, cur, wr, wc, fr, fq, lds, wid, lane); S.done(cur); }
#undef PG8_SA
#undef PG8_SB
#undef PG8_STAGE
#undef PG8_LDA
#undef PG8_LDB
#undef PG8_MMA
#undef PG8_WAIT_V
#undef PG8_WAIT_L
#undef PG8_BAR
#undef PG8_SCHED
}
}
constexpr int NWAVES = 8;
constexpr int BATCH = 2, T = 16384, M = BATCH * T, D = 2048, NIN = 7424, DFF = 8192;
constexpr int NA = 3328, NB = 4096;
constexpr int DR = 1024;
constexpr int NLORA = 256;
constexpr float LN_EPS = 1e-5f, RWKV_GN_EPS = 64e-5f, RET_GN_EPS = 1e-6f;
constexpr float ALPHA = 1.189207115002721f;
constexpr size_t MiB = 1u << 20;
constexpr size_t WS_CTL = 0, WS_WL = 1 * MiB, WS_BON = 3 * MiB, WS_WIN = 8 * MiB, WS_WO = 38 * MiB, WS_WUP = 46 * MiB, WS_WDN = 78 * MiB;
constexpr size_t WS_XB = 112 * MiB;
constexpr size_t WS_HA = 240 * MiB, WS_MIX = 240 * MiB, WS_HB = 448 * MiB;
constexpr size_t WS_G = 704 * MiB, WS_P5 = 768 * MiB, WS_P6 = 832 * MiB, WS_LRW = 896 * MiB, WS_LRA = 960 * MiB, WS_END = 1024 * MiB;
constexpr size_t WS_U = 240 * MiB, WS_X1B = 768 * MiB;
constexpr size_t OUT_AP = 0;
static_assert(WS_HA + (size_t)M * NA * 2 <= WS_HB && WS_HB + (size_t)M * NB * 2 <= WS_G && WS_U + (size_t)M * DFF * 2 <= WS_X1B, "ws map");
constexpr int N1A = NA + 256;
constexpr int LDS_BYTES = 163840;
#define LAS __attribute__((address_space(3)))
typedef unsigned short bf16;
typedef unsigned short f16b;
typedef float f32x4 __attribute__((ext_vector_type(4)));
typedef float f32x2 __attribute__((ext_vector_type(2)));
typedef unsigned u32x4 __attribute__((ext_vector_type(4)));
typedef unsigned u32x2 __attribute__((ext_vector_type(2)));
typedef short bf16x8 __attribute__((ext_vector_type(8)));
typedef _Float16 h16x2 __attribute__((ext_vector_type(2)));
typedef _Float16 h16x8 __attribute__((ext_vector_type(8)));
#define LDS_WAIT() asm volatile("s_waitcnt lgkmcnt(0)" ::: "memory")

__device__ __forceinline__ unsigned f2bf(float f) { unsigned u = __builtin_bit_cast(unsigned, f); return (u + 0x7fffu + ((u >> 16) & 1u)) >> 16; }
__device__ __forceinline__ unsigned pk2(float lo, float hi) { return f2bf(lo) | (f2bf(hi) << 16); }
__device__ __forceinline__ float bf_lo(unsigned w) { return __builtin_bit_cast(float, w << 16); }
__device__ __forceinline__ float bf_hi(unsigned w) { return __builtin_bit_cast(float, w & 0xffff0000u); }
__device__ __forceinline__ float bf1(bf16 v) { return __builtin_bit_cast(float, (unsigned)v << 16); }
__device__ __forceinline__ unsigned pkh(float lo, float hi) { h16x2 v; v.x = (_Float16)lo; v.y = (_Float16)hi; return __builtin_bit_cast(unsigned, v); }
__device__ __forceinline__ float h_lo(unsigned w) { h16x2 v = __builtin_bit_cast(h16x2, w); return (float)v.x; }
__device__ __forceinline__ float h_hi(unsigned w) { h16x2 v = __builtin_bit_cast(h16x2, w); return (float)v.y; }
__device__ __forceinline__ float wave_sum(float v) {
#pragma unroll
    for (int o = 1; o < 64; o <<= 1) v += __shfl_xor(v, o);
    return v;
}
template <int CTRL> __device__ __forceinline__ float dpp_mov(float x) { return __builtin_bit_cast(float, __builtin_amdgcn_update_dpp(0, __builtin_bit_cast(int, x), CTRL, 0xF, 0xF, true)); }
__device__ __forceinline__ float row16_sum(float x) { x += dpp_mov<0x128>(x); x += dpp_mov<0x124>(x); x += dpp_mov<0x122>(x); x += dpp_mov<0x121>(x); return x; }
__device__ __forceinline__ float fma_s(float a, float b, float c) { float d; asm("v_fma_f32 %0, %1, %2, %3" : "=v"(d) : "v"(a), "v"(b), "v"(c)); return d; }
__device__ __forceinline__ float fnma_s(float a, float b, float c) { float d; asm("v_fma_f32 %0, -%1, %2, %3" : "=v"(d) : "v"(a), "v"(b), "v"(c)); return d; }
__device__ __forceinline__ float mul_s(float a, float b) { float d; asm("v_mul_f32 %0, %1, %2" : "=v"(d) : "v"(a), "v"(b)); return d; }
__device__ __forceinline__ float sigmoidf_(float x) { return 1.f / (1.f + __expf(-x)); }

struct Args { const float* in[21]; float* out; unsigned char* ws; int ph_lo, ph_hi, coop, klora, reps, pad; };
struct Frame {
    LAS unsigned char* lds; unsigned char* ws; float* out;
    int tid, lane, wave, G, gw, NGW;
};

__device__ __forceinline__ void p0_transpose_item(const float* W, int K, int N, bf16* WT, LAS float* scr, int item, int lane, bool remap) {
    const int nblk = N / 32, kb = item / nblk, nb = item % nblk, k0 = 64 * kb, n0 = 32 * nb;
    const int nd = !remap ? n0 : (n0 < NA ? n0 : (n0 >= 6400 ? n0 - 6400 + NA : n0 + 1024));
#pragma unroll 32
    for (int i = 0; i < 32; ++i) { const int kk = 2 * i + (lane >> 5); scr[kk * 33 + (lane & 31)] = W[(size_t)(k0 + kk) * N + n0 + (lane & 31)]; }
    LDS_WAIT(); asm volatile("" ::: "memory");
    const int c = lane & 7;
#pragma unroll
    for (int j = 0; j < 4; ++j) { const int n = (lane >> 3) + 8 * j; const LAS float* s = scr + (8 * c) * 33 + n;
        u32x4 o; o.x = pk2(s[0 * 33], s[1 * 33]); o.y = pk2(s[2 * 33], s[3 * 33]); o.z = pk2(s[4 * 33], s[5 * 33]); o.w = pk2(s[6 * 33], s[7 * 33]);
        *(u32x4*)(WT + (size_t)(nd + n) * K + k0 + 8 * c) = o; }
    LDS_WAIT(); asm volatile("" ::: "memory");
}
__device__ __forceinline__ void p0_late_weights(Frame& F, const Args& a, int w, int nw) {
    LAS float* scr = (LAS float*)(F.lds + F.wave * 16384);
    const float *w_o = a.in[14], *w_up = a.in[17], *w_dn = a.in[18];
    bf16 *WO = (bf16*)(F.ws + WS_WO), *WUP = (bf16*)(F.ws + WS_WUP), *WDN = (bf16*)(F.ws + WS_WDN);
    constexpr int I_O = (D / 64) * (D / 32), I_UP = (D / 64) * (DFF / 32), I_DN = (DFF / 64) * (D / 32);
    for (int it = w; it < I_O + I_UP + I_DN; it += nw) {
        int r = it;
        if (r < I_O) { p0_transpose_item(w_o, D, D, WO, scr, r, F.lane, false); continue; } r -= I_O;
        if (r < I_UP) { p0_transpose_item(w_up, D, DFF, WUP, scr, r, F.lane, false); continue; } r -= I_UP;
        p0_transpose_item(w_dn, DFF, D, WDN, scr, r, F.lane, false);
    }
}
__device__ __forceinline__ void p0_prologue(Frame& F, const Args& a) {
    LAS float* scr = (LAS float*)(F.lds + F.wave * 16384);
    { const float* w_in = a.in[1]; bf16* WIN = (bf16*)(F.ws + WS_WIN);
      constexpr int I_IN = (D / 64) * (NIN / 32);
      for (int it = F.gw; it < I_IN; it += F.NGW) p0_transpose_item(w_in, D, NIN, WIN, scr, it, F.lane, false); }
    const int gt = F.gw * 64 + F.lane, NGT = F.NGW * 64;
    { bf16* WL = (bf16*)(F.ws + WS_WL); const float *wl = a.in[4], *al = a.in[6], *gl = a.in[7];
      for (int idx = gt; idx < 3072 * NLORA; idx += NGT) { const int n = idx >> 8, k = idx & 255; float v = 0.f;
          if (n < 1024) { if (k < 64) v = wl[k * 1024 + n]; }
          else if (n < 2048) { if (k >= 64 && k < 128) v = al[(k - 64) * 1024 + (n - 1024)]; }
          else { if (k >= 128) v = gl[(k - 128) * 1024 + (n - 2048)]; }
          WL[idx] = (bf16)f2bf(v); } }
    { const float* x = a.in[0]; bf16* XB = (bf16*)(F.ws + WS_XB);
      for (size_t c = gt; c < (size_t)M * D / 8; c += (size_t)4 * NGT) { f32x4 v0[4], v1[4];
#pragma unroll
          for (int q = 0; q < 4; ++q) { const size_t cc = c + (size_t)q * NGT; v0[q] = *(const f32x4*)(x + cc * 8); v1[q] = *(const f32x4*)(x + cc * 8 + 4); }
#pragma unroll
          for (int q = 0; q < 4; ++q) { const size_t cc = c + (size_t)q * NGT; u32x4 o; o.x = pk2(v0[q].x, v0[q].y); o.y = pk2(v0[q].z, v0[q].w); o.z = pk2(v1[q].x, v1[q].y); o.w = pk2(v1[q].z, v1[q].w); *(u32x4*)(XB + cc * 8) = o; } } }
}

template <bool IN16> __device__ __forceinline__ void ln_pass(Frame& F, const void* in, const bf16* add, float* out, bf16* outb, const float* w, const float* b) {
    for (int m0 = 2 * F.gw; m0 < M; m0 += 2 * F.NGW) {
        f32x4 v[2][8]; u32x2 av[2][8], iv[2][8]; float s[2] = {0.f, 0.f};
#pragma unroll
        for (int r = 0; r < 2; ++r) { const u32x2* ar = (const u32x2*)(add + (size_t)(m0 + r) * D) + F.lane;
#pragma unroll
            for (int j = 0; j < 8; ++j) { av[r][j] = ar[64 * j];
                if (IN16) iv[r][j] = ((const u32x2*)((const bf16*)in + (size_t)(m0 + r) * D) + F.lane)[64 * j];
                else v[r][j] = ((const f32x4*)((const float*)in + (size_t)(m0 + r) * D) + F.lane)[64 * j]; } }
#pragma unroll
        for (int r = 0; r < 2; ++r) {
#pragma unroll
            for (int j = 0; j < 8; ++j) { if (IN16) v[r][j] = (f32x4){bf_lo(iv[r][j].x), bf_hi(iv[r][j].x), bf_lo(iv[r][j].y), bf_hi(iv[r][j].y)};
                v[r][j] = v[r][j] * ALPHA + (f32x4){bf_lo(av[r][j].x), bf_hi(av[r][j].x), bf_lo(av[r][j].y), bf_hi(av[r][j].y)}; s[r] += (v[r][j].x + v[r][j].y) + (v[r][j].z + v[r][j].w); }
            const float mean = wave_sum(s[r]) * (1.f / D); float s2 = 0.f;
#pragma unroll
            for (int j = 0; j < 8; ++j) { v[r][j] = v[r][j] - mean; s2 += (v[r][j].x * v[r][j].x + v[r][j].y * v[r][j].y) + (v[r][j].z * v[r][j].z + v[r][j].w * v[r][j].w); }
            const float rstd = 1.f / sqrtf(wave_sum(s2) * (1.f / D) + LN_EPS);
#pragma unroll
            for (int j = 0; j < 8; ++j) { const f32x4 wv = ((const f32x4*)w)[64 * j + F.lane], bv = ((const f32x4*)b)[64 * j + F.lane];
                const f32x4 q = v[r][j] * rstd * wv + bv;
                if (out) ((f32x4*)(out + (size_t)(m0 + r) * D) + F.lane)[64 * j] = q;
                if (outb) { u32x2 p; p.x = pk2(q.x, q.y); p.y = pk2(q.z, q.w); *((u32x2*)(outb + (size_t)(m0 + r) * D) + 64 * j + F.lane) = p; } }
        }
    }
}

__device__ __forceinline__ void p2a_prep(Frame& F, const Args& a) {
    const bf16* HA = (const bf16*)(F.ws + WS_HA); bf16* AP = (bf16*)((unsigned char*)F.out + OUT_AP);
    const int j0 = 4 * F.lane; const f32x4 mu4 = *(const f32x4*)(a.in[2] + 3072 + j0);
#pragma unroll 2
    for (int m = F.gw; m < M; m += F.NGW) {
        const int t = m & (T - 1);
        const u32x2 cur = *(const u32x2*)(HA + (size_t)m * NA + 3072 + j0); u32x2 prv = (u32x2){0u, 0u};
        if (t > 0) prv = *(const u32x2*)(HA + (size_t)(m - 1) * NA + 3072 + j0);
        float c[4] = {bf_lo(cur.x), bf_hi(cur.x), bf_lo(cur.y), bf_hi(cur.y)}, p[4] = {bf_lo(prv.x), bf_hi(prv.x), bf_lo(prv.y), bf_hi(prv.y)};
        const float mu[4] = {mu4.x, mu4.y, mu4.z, mu4.w}; float f[4];
#pragma unroll
        for (int e = 0; e < 4; ++e) { float v = c[e] + (p[e] - c[e]) * mu[e];
            if (F.lane < 16) v = 1.f - 2.f / (1.f + __expf(2.f * v));
            else if (F.lane >= 32) v = sigmoidf_(v);
            f[e] = v; }
        u32x2 o; o.x = pk2(f[0], f[1]); o.y = pk2(f[2], f[3]); *(u32x2*)(AP + (size_t)m * NLORA + j0) = o;
    }
}
__device__ __forceinline__ void ret_rotary(Frame& F, int w, int nw) {
    bf16* HB = (bf16*)(F.ws + WS_HB);
    const float if0 = 1.0f / exp2f((float)F.lane * (13.287712379549449f / 127.0f)), if1 = 1.0f / exp2f((float)(64 + F.lane) * (13.287712379549449f / 127.0f));
    for (int m = w; m < M; m += nw) {
        const int t = m & (T - 1);
        const float th0 = (float)t * if0, th1 = (float)t * if1;
        const double r0 = (double)th0 * 0.15915494309189535, r1 = (double)th1 * 0.15915494309189535;
        const float f0 = (float)(r0 - __builtin_rint(r0)), f1 = (float)(r1 - __builtin_rint(r1));
        const float c0 = __builtin_amdgcn_cosf(f0), s0 = __builtin_amdgcn_sinf(f0), c1 = __builtin_amdgcn_cosf(f1), s1 = __builtin_amdgcn_sinf(f1);
        unsigned qv[8], kv[8];
#pragma unroll
        for (int it = 0; it < 8; ++it) { const int p = it * 64 + F.lane, hd = p >> 7, i = p & 127;
            qv[it] = *(const unsigned*)(HB + (size_t)m * NB + hd * 256 + 2 * i); kv[it] = *(const unsigned*)(HB + (size_t)m * NB + 1024 + hd * 256 + 2 * i); }
#pragma unroll
        for (int it = 0; it < 8; ++it) { const int p = it * 64 + F.lane, hd = p >> 7, i = p & 127; const float cs = (it & 1) ? c1 : c0, sn = (it & 1) ? s1 : s0;
            const float q1 = bf_lo(qv[it]), q2 = bf_hi(qv[it]), k1 = bf_lo(kv[it]), k2 = bf_hi(kv[it]);
            *(unsigned*)(HB + (size_t)m * NB + hd * 256 + 2 * i) = pk2(q1 * cs - q2 * sn, q1 * sn + q2 * cs);
            *(unsigned*)(HB + (size_t)m * NB + 1024 + hd * 256 + 2 * i) = pk2((k1 * cs - k2 * sn) * 0.0625f, (k1 * sn + k2 * cs) * 0.0625f); }
    }
}
#define XB_TMO      128
#define XB_XCNT(j)  (256  + 64 * (j))
#define XB_XSUB(j)  (1280 + 64 * (j))
#define XB_XGEN(j)  (2304 + 64 * (j))
#define XB_TOP      3328
#define XB_TOPGEN   3392
#define XCD_BAR_WORDS 3456
#define XB_SPIN_CAP (1u << 18)

__device__ __forceinline__ unsigned xb_ld(unsigned* p)              { return __hip_atomic_load(p, __ATOMIC_RELAXED, __HIP_MEMORY_SCOPE_AGENT); }
__device__ __forceinline__ unsigned xb_add(unsigned* p, unsigned v) { return __hip_atomic_fetch_add(p, v, __ATOMIC_RELAXED, __HIP_MEMORY_SCOPE_AGENT); }
__device__ __forceinline__ unsigned xb_xcc_id() { return (unsigned)__builtin_amdgcn_s_getreg((3 << 11) | 20) & 0xFu; }
#define XB_SPIN(cond, bar) do { unsigned _sp = 0; while (cond) { __builtin_amdgcn_s_sleep(1); \
    if ((++_sp & 255u) == 0u) { if (xb_ld(&(bar)[XB_TMO])) break; if (_sp > XB_SPIN_CAP) { atomicAdd(&(bar)[XB_TMO], 1u); break; } } } } while (0)

struct XcdBarrier {
    unsigned* bar; unsigned x;
    volatile LAS unsigned* st;
};

__device__ __forceinline__ XcdBarrier xcd_barrier_post(unsigned* bar, volatile LAS unsigned* st) {
    XcdBarrier b; b.bar = bar; b.x = xb_xcc_id(); b.st = st;
    if (threadIdx.x == 0) (void)xb_add(&bar[XB_XCNT(b.x)], 1u);
    return b;
}
__device__ __forceinline__ void xcd_barrier_complete(unsigned* bar, unsigned x, unsigned& nloc, unsigned& nx) {
    const unsigned G = gridDim.x * gridDim.y * gridDim.z;
    unsigned sum, cnt, mine, sp = 0u;
    for (;;) {
        sum = 0u; cnt = 0u; mine = 0u;
#pragma unroll
        for (unsigned j = 0; j < 16; ++j) { const unsigned c = xb_ld(&bar[XB_XCNT(j)]); sum += c; cnt += (c > 0u) ? 1u : 0u; mine = (j == x) ? c : mine; }
        if (sum == G) break;
        __builtin_amdgcn_s_sleep(1);
        if ((++sp & 255u) == 0u) { if (xb_ld(&bar[XB_TMO])) break; if (sp > XB_SPIN_CAP) { atomicAdd(&bar[XB_TMO], 1u); break; } }
    }
    nloc = mine > 0u ? mine : 1u; nx = cnt > 0u ? cnt : 1u;
}

__device__ __forceinline__ void xcd_barrier(const XcdBarrier& b) {
    asm volatile("s_waitcnt vmcnt(0)" ::: "memory");
    __syncthreads();
    if (threadIdx.x == 0) {
        unsigned* bar = b.bar;
        __builtin_amdgcn_s_waitcnt(0);
        unsigned nloc = b.st[0], nx = b.st[1];
        if (nloc == 0u) { xcd_barrier_complete(bar, b.x, nloc, nx); b.st[0] = nloc; b.st[1] = nx; }
        const unsigned old = xb_add(&bar[XB_XSUB(b.x)], 1u);
        const unsigned gen = old / nloc;
        if (old + 1u == (gen + 1u) * nloc) {
            __builtin_amdgcn_fence(__ATOMIC_RELEASE, "agent");
            asm volatile("s_waitcnt vmcnt(0)" ::: "memory");
            const unsigned og = xb_add(&bar[XB_TOP], 1u);
            const unsigned tg = og / nx;
            if (og + 1u == (tg + 1u) * nx) xb_add(&bar[XB_TOPGEN], 1u);
            else XB_SPIN(xb_ld(&bar[XB_TOPGEN]) == tg, bar);
            __builtin_amdgcn_fence(__ATOMIC_ACQUIRE, "agent");
            xb_add(&bar[XB_XGEN(b.x)], 1u);
            asm volatile("s_waitcnt vmcnt(0)" ::: "memory");
        } else {
            XB_SPIN(xb_ld(&bar[XB_XGEN(b.x)]) == gen, bar);
            __builtin_amdgcn_fence(__ATOMIC_ACQUIRE, "agent");
            asm volatile("s_waitcnt vmcnt(0)" ::: "memory");
        }
    }
    __syncthreads();
}

__device__ __forceinline__ void sub_barrier(unsigned* ctr, unsigned target) {
    asm volatile("s_waitcnt vmcnt(0)" ::: "memory");
    __syncthreads();
    if (threadIdx.x == 0) {
        __builtin_amdgcn_fence(__ATOMIC_RELEASE, "agent");
        asm volatile("s_waitcnt vmcnt(0)" ::: "memory");
        __hip_atomic_fetch_add(ctr, 1u, __ATOMIC_RELAXED, __HIP_MEMORY_SCOPE_AGENT);
        while (__hip_atomic_load(ctr, __ATOMIC_RELAXED, __HIP_MEMORY_SCOPE_AGENT) < target) __builtin_amdgcn_s_sleep(2);
        __builtin_amdgcn_fence(__ATOMIC_ACQUIRE, "agent");
        asm volatile("s_waitcnt vmcnt(0)" ::: "memory");
    }
    __syncthreads();
}

struct Prep { f16b *r, *x, *km, *v, *kk, *b; float* bon; };
__device__ __forceinline__ Prep prep_ptrs(Frame& F) { Prep p; f16b* o = (f16b*)F.out; const size_t S = (size_t)M * DR;
    p.r = o; p.x = o + S; p.km = o + 2 * S; p.v = o + 3 * S; p.kk = (f16b*)(F.ws + WS_P5); p.b = (f16b*)(F.ws + WS_P6); p.bon = (float*)(F.ws + WS_BON); return p; }
__device__ __forceinline__ void p2c_rwkv_prep(Frame& F, const Args& a) {
    const bf16* HA = (const bf16*)(F.ws + WS_HA); const f16b* LRW = (const f16b*)(F.ws + WS_LRW); const f16b* LRA = (const f16b*)(F.ws + WS_LRA);
    const Prep P = prep_ptrs(F);
    const int qd = F.gw & 3, c0 = 256 * qd + 4 * F.lane, hd = c0 >> 6;
    const f32x4 mu_r = *(const f32x4*)(a.in[2] + c0), mu_k = *(const f32x4*)(a.in[2] + 1024 + c0), mu_v = *(const f32x4*)(a.in[2] + 2048 + c0);
    const f32x4 w0 = *(const f32x4*)(a.in[3] + c0), a0 = *(const f32x4*)(a.in[5] + c0), k_k = *(const f32x4*)(a.in[8] + c0), k_a = *(const f32x4*)(a.in[9] + c0), r_k = *(const f32x4*)(a.in[10] + c0);
    const int NI = F.NGW >> 2;
#pragma unroll 4
    for (int m = F.gw >> 2; m < M; m += NI) {
        const int t = m & (T - 1); const bf16* row = HA + (size_t)m * NA + c0; const size_t o = (size_t)m * DR + c0;
        const u32x2 cr = *(const u32x2*)(row), ck = *(const u32x2*)(row + 1024), cv = *(const u32x2*)(row + 2048);
        u32x2 pr = (u32x2){0u, 0u}, pk = pr, pv = pr;
        if (t > 0) { pr = *(const u32x2*)(row - NA); pk = *(const u32x2*)(row - NA + 1024); pv = *(const u32x2*)(row - NA + 2048); }
        const u32x2 lw = *(const u32x2*)(LRW + o), la = *(const u32x2*)(LRA + o);
        float r[4], k[4], v[4], x[4], as[4], kk[4], km[4]; float n2 = 0.f, bon = 0.f;
#pragma unroll
        for (int e = 0; e < 4; ++e) {
            const unsigned wr_ = cr[e >> 1], wk_ = ck[e >> 1], wv_ = cv[e >> 1], qr_ = pr[e >> 1], qk_ = pk[e >> 1], qv_ = pv[e >> 1];
            const float hr = (e & 1) ? bf_hi(wr_) : bf_lo(wr_), hk = (e & 1) ? bf_hi(wk_) : bf_lo(wk_), hv = (e & 1) ? bf_hi(wv_) : bf_lo(wv_);
            const float gr = (e & 1) ? bf_hi(qr_) : bf_lo(qr_), gk = (e & 1) ? bf_hi(qk_) : bf_lo(qk_), gv = (e & 1) ? bf_hi(qv_) : bf_lo(qv_);
            r[e] = hr + (gr - hr) * mu_r[e]; k[e] = hk + (gk - hk) * mu_k[e]; v[e] = hv + (gv - hv) * mu_v[e];
            const float wpre = w0[e] + ((e & 1) ? h_hi(lw[e >> 1]) : h_lo(lw[e >> 1])), apre = a0[e] + ((e & 1) ? h_hi(la[e >> 1]) : h_lo(la[e >> 1]));
            const float z = -wpre; const float sp = fmaxf(z, 0.f) + __logf(1.f + __expf(-fabsf(z)));
            const float ew = __expf(-sp - 0.5f); x[e] = 1.f - __expf(-ew);
            as[e] = sigmoidf_(apre); kk[e] = k[e] * k_k[e]; n2 += kk[e] * kk[e];
            km[e] = k[e] * (1.f + (as[e] - 1.f) * k_a[e]); bon += r[e] * km[e] * r_k[e]; }
        n2 = row16_sum(n2); bon = row16_sum(bon);
        const float inv = 1.f / fmaxf(sqrtf(n2), 1e-12f);
#pragma unroll
        for (int e = 0; e < 4; ++e) kk[e] *= inv;
        *(u32x2*)(P.r + o) = (u32x2){pkh(r[0], r[1]), pkh(r[2], r[3])}; *(u32x2*)(P.x + o) = (u32x2){pkh(x[0], x[1]), pkh(x[2], x[3])};
        *(u32x2*)(P.km + o) = (u32x2){pkh(km[0], km[1]), pkh(km[2], km[3])}; *(u32x2*)(P.v + o) = (u32x2){pkh(v[0], v[1]), pkh(v[2], v[3])};
        *(u32x2*)(P.kk + o) = (u32x2){pkh(kk[0], kk[1]), pkh(kk[2], kk[3])}; *(u32x2*)(P.b + o) = (u32x2){pkh(kk[0] * as[0], kk[1] * as[1]), pkh(kk[2] * as[2], kk[3] * as[3])};
        if ((F.lane & 15) == 0) P.bon[(size_t)m * 16 + hd] = bon;
    }
}
constexpr int RC = 32;
constexpr int RB_VEC = 0, RB_SCL = 16 * 9 * 64, RB_V = RB_SCL + 16 * 12, RB_Y = RB_V + RC * 16, RB_FLOATS = RB_Y + RC * 256;
static_assert(2 * RB_FLOATS * 4 <= LDS_BYTES, "rwkv scan LDS");
__device__ __forceinline__ void rwkv_scan_unit(Frame& F, int unit) {
    const int bh = unit >> 2, rg = unit & 3, b = bh >> 4, h = bh & 15; const size_t m0 = (size_t)b * T; const int ch0 = h * 64;
    const Prep P = prep_ptrs(F); bf16* MIX = (bf16*)(F.ws + WS_MIX);
    LAS float* L = (LAS float*)F.lds;
    constexpr int NCH = T / RC;
    if (F.wave >= 4) {
        const int ht = F.tid - 256, pp = ht >> 4, c4 = (ht & 15) * 4, s = ht >> 3, c8 = ht & 7;
        u32x2 qr[2][2], qx[2][2], qk[2][2], qa[2][2], qb[2][2]; unsigned qv[2];
#define RW_LOAD(c, S_) do { \
        _Pragma("unroll") for (int u_ = 0; u_ < 2; ++u_) { const size_t o_ = (m0 + (size_t)(c) * RC + 2 * pp + u_) * DR + ch0 + c4; \
            qr[S_][u_] = *(const u32x2*)(P.r + o_); qx[S_][u_] = *(const u32x2*)(P.x + o_); qk[S_][u_] = *(const u32x2*)(P.km + o_); qa[S_][u_] = *(const u32x2*)(P.kk + o_); qb[S_][u_] = *(const u32x2*)(P.b + o_); } \
        qv[S_] = *(const unsigned*)(P.v + (m0 + (size_t)(c) * RC + s) * DR + ch0 + 16 * rg + 2 * c8); } while (0)
#define RW_WRITE(buf, S_) do { LAS float* B_ = L + (buf) * RB_FLOATS; float c1_ = 0.f, c2_ = 0.f, br0_ = 0.f, kr0_ = 0.f, d1_ = 0.f, d2_ = 0.f, br1_ = 0.f, kr1_ = 0.f; \
        f32x4 o_[9]; \
        _Pragma("unroll") for (int e_ = 0; e_ < 4; ++e_) { \
            const unsigned wr0u = qr[S_][0][e_ >> 1], wx0u = qx[S_][0][e_ >> 1], wk0u = qk[S_][0][e_ >> 1], wa0u = qa[S_][0][e_ >> 1], wb0u = qb[S_][0][e_ >> 1]; \
            const unsigned wr1u = qr[S_][1][e_ >> 1], wx1u = qx[S_][1][e_ >> 1], wk1u = qk[S_][1][e_ >> 1], wa1u = qa[S_][1][e_ >> 1], wb1u = qb[S_][1][e_ >> 1]; \
            const float r0 = (e_ & 1) ? h_hi(wr0u) : h_lo(wr0u), w0 = 1.f - ((e_ & 1) ? h_hi(wx0u) : h_lo(wx0u)), k0 = (e_ & 1) ? h_hi(wk0u) : h_lo(wk0u), a0 = (e_ & 1) ? h_hi(wa0u) : h_lo(wa0u), b0 = (e_ & 1) ? h_hi(wb0u) : h_lo(wb0u); \
            const float r1 = (e_ & 1) ? h_hi(wr1u) : h_lo(wr1u), w1 = 1.f - ((e_ & 1) ? h_hi(wx1u) : h_lo(wx1u)), k1 = (e_ & 1) ? h_hi(wk1u) : h_lo(wk1u), a1 = (e_ & 1) ? h_hi(wa1u) : h_lo(wa1u), b1 = (e_ & 1) ? h_hi(wb1u) : h_lo(wb1u); \
            const float wr1 = w1 * r1; \
            o_[0][e_] = a0; o_[1][e_] = w0 * r0; o_[2][e_] = w0 * a1; o_[3][e_] = w0 * wr1; o_[4][e_] = w0 * w1; o_[5][e_] = k0 * w1; o_[6][e_] = b0 * w1; o_[7][e_] = k1; o_[8][e_] = b1; \
            c1_ += b0 * a1; c2_ += k0 * a1; br0_ += b0 * r0; kr0_ += k0 * r0; d1_ += b0 * wr1; d2_ += k0 * wr1; br1_ += b1 * r1; kr1_ += k1 * r1; } \
        _Pragma("unroll") for (int j_ = 0; j_ < 9; ++j_) *(LAS f32x4*)(B_ + RB_VEC + (pp * 9 + j_) * 64 + c4) = o_[j_]; \
        c1_ = row16_sum(c1_); c2_ = row16_sum(c2_); br0_ = row16_sum(br0_); kr0_ = row16_sum(kr0_); d1_ = row16_sum(d1_); d2_ = row16_sum(d2_); br1_ = row16_sum(br1_); kr1_ = row16_sum(kr1_); \
        if ((ht & 15) == 0) { *(LAS f32x4*)(B_ + RB_SCL + pp * 12) = (f32x4){c1_, c2_, br0_ * 0.0625f, kr0_ * 0.0625f}; *(LAS f32x4*)(B_ + RB_SCL + pp * 12 + 4) = (f32x4){d1_ * 0.0625f, d2_ * 0.0625f, br1_ * 0.0625f, kr1_ * 0.0625f}; } \
        *(LAS f32x2*)(B_ + RB_V + s * 16 + 2 * c8) = (f32x2){h_lo(qv[S_]), h_hi(qv[S_])}; } while (0)
#define RW_STOREY(buf, c) do { const LAS float* B_ = L + (buf) * RB_FLOATS; float y_[2]; \
        _Pragma("unroll") for (int q_ = 0; q_ < 2; ++q_) { const LAS f32x4* yp_ = (const LAS f32x4*)(B_ + RB_Y + (s * 16 + 2 * c8 + q_) * 16); \
            const f32x4 a_ = yp_[0], b_ = yp_[1], c_ = yp_[2], d_ = yp_[3]; \
            y_[q_] = ((a_.x + a_.y) + (a_.z + a_.w)) + ((b_.x + b_.y) + (b_.z + b_.w)) + (((c_.x + c_.y) + (c_.z + c_.w)) + ((d_.x + d_.y) + (d_.z + d_.w))); } \
        *(unsigned*)(MIX + (m0 + (size_t)(c) * RC + s) * D + ch0 + 16 * rg + 2 * c8) = pk2(y_[0], y_[1]); } while (0)
        RW_LOAD(0, 0); RW_WRITE(0, 0); RW_LOAD(1, 1); RW_LOAD(2, 0);
        __syncthreads();
        for (int c = 0; c < NCH; c += 2) {
            if (c + 1 < NCH) RW_WRITE(1, 1);
            if (c + 3 < NCH) RW_LOAD(c + 3, 1);
            if (c > 0) RW_STOREY(1, c - 1);
            __syncthreads();
            if (c + 2 < NCH) RW_WRITE(0, 0);
            if (c + 4 < NCH) RW_LOAD(c + 4, 0);
            RW_STOREY(0, c);
            __syncthreads();
        }
        RW_STOREY((NCH - 1) & 1, NCH - 1);
#undef RW_LOAD
#undef RW_WRITE
#undef RW_STOREY
    } else {
        const int g4 = F.lane >> 4, l = F.lane & 15, vrow = F.wave * 4 + g4;
        f32x2 Sa = (f32x2){0.f, 0.f}, Sb = (f32x2){0.f, 0.f};
        struct PairV { f32x4 v[9]; f32x4 sa, sb; float vv0, vv1; };
#define SC_LD(d, p_) do { _Pragma("unroll") for (int j_ = 0; j_ < 9; ++j_) d.v[j_] = *(const LAS f32x4*)(B + RB_VEC + ((p_) * 9 + j_) * 64 + 4 * l); \
        d.sa = *(const LAS f32x4*)(B + RB_SCL + (p_) * 12); d.sb = *(const LAS f32x4*)(B + RB_SCL + (p_) * 12 + 4); d.vv0 = B[RB_V + (2 * (p_)) * 16 + vrow]; d.vv1 = B[RB_V + (2 * (p_) + 1) * 16 + vrow]; } while (0)
#define LO2(q_) ((f32x2){(q_).x, (q_).y})
#define HI2(q_) ((f32x2){(q_).z, (q_).w})
#define SC_PAIR(d, p_) do { \
        const f32x2 t1 = Sa * LO2(d.v[0]) + Sb * HI2(d.v[0]), t2 = Sa * LO2(d.v[1]) + Sb * HI2(d.v[1]), t3 = Sa * LO2(d.v[2]) + Sb * HI2(d.v[2]), t4 = Sa * LO2(d.v[3]) + Sb * HI2(d.v[3]); \
        const float p1 = row16_sum(t1.x + t1.y), r3 = row16_sum(t3.x + t3.y); \
        const float p1n = r3 - p1 * d.sa.x + d.vv0 * d.sa.y; \
        Y[(2 * (p_)) * 256 + vrow * 16 + l] = (t2.x + t2.y) + (d.vv0 * d.sa.w - p1 * d.sa.z); \
        Y[(2 * (p_) + 1) * 256 + vrow * 16 + l] = (t4.x + t4.y) + ((d.vv0 * d.sb.y - p1 * d.sb.x) + (d.vv1 * d.sb.w - p1n * d.sb.z)); \
        const f32x2 ea = (LO2(d.v[5]) * d.vv0 - LO2(d.v[6]) * p1) + (LO2(d.v[7]) * d.vv1 - LO2(d.v[8]) * p1n), eb = (HI2(d.v[5]) * d.vv0 - HI2(d.v[6]) * p1) + (HI2(d.v[7]) * d.vv1 - HI2(d.v[8]) * p1n); \
        Sa = Sa * LO2(d.v[4]) + ea; Sb = Sb * HI2(d.v[4]) + eb; } while (0)
        __syncthreads();
        for (int c = 0; c < NCH; ++c) {
            const LAS float* B = L + (c & 1) * RB_FLOATS; LAS float* Y = L + (c & 1) * RB_FLOATS + RB_Y;
            PairV a0, a1;
            SC_LD(a0, 0);
#pragma unroll
            for (int p = 0; p < RC / 2; p += 2) {
                SC_LD(a1, p + 1);
                SC_PAIR(a0, p);
                if (p + 2 < RC / 2) SC_LD(a0, p + 2);
                SC_PAIR(a1, p + 1);
            }
            __syncthreads();
        }
#undef SC_LD
#undef SC_PAIR
#undef LO2
#undef HI2
    }
}

constexpr size_t WS_KT = 896 * MiB, WS_VT = 960 * MiB;
constexpr int TR_P = 136;
static_assert(2 * 256 * TR_P * 2 <= LDS_BYTES, "transpose LDS");
__device__ __forceinline__ float ret_lg2gamma(int h) { return log2f(1.0f - exp2f(-5.0f - (float)h)); }
__device__ __forceinline__ void ret_transpose_unit(Frame& F, int unit) {
    const int n = unit & 127, bh = unit >> 7, b = bh >> 2, h = bh & 3;
    const bf16* HB = (const bf16*)(F.ws + WS_HB); bf16* KT = (bf16*)(F.ws + WS_KT) + (size_t)unit * 32768; bf16* VT = (bf16*)(F.ws + WS_VT) + (size_t)unit * 32768;
    LAS bf16* TK = (LAS bf16*)F.lds; LAS bf16* TV = TK + 256 * TR_P;
    const int w = F.wave, cl = F.lane & 15, dq = F.lane >> 4, c = 16 * w + cl;
    const float dk = exp2f((float)(127 - c) * ret_lg2gamma(h));
    const size_t r0 = (size_t)b * T + (size_t)n * 128;
    u32x4 kreg[8], vreg[8];
#pragma unroll
    for (int i = 0; i < 8; ++i) { kreg[i] = *(const u32x4*)(HB + (r0 + c) * NB + 1024 + h * 256 + (4 * i + dq) * 8); vreg[i] = *(const u32x4*)(HB + (r0 + c) * NB + 2048 + h * 256 + (4 * i + dq) * 8); }
#pragma unroll
    for (int i = 0; i < 8; ++i) { const int d0 = (4 * i + dq) * 8;
#pragma unroll
        for (int e = 0; e < 4; ++e) { TK[(d0 + 2 * e) * TR_P + c] = (bf16)f2bf(bf_lo(kreg[i][e]) * dk); TK[(d0 + 2 * e + 1) * TR_P + c] = (bf16)f2bf(bf_hi(kreg[i][e]) * dk);
            TV[(d0 + 2 * e) * TR_P + c] = (bf16)(vreg[i][e] & 0xffffu); TV[(d0 + 2 * e + 1) * TR_P + c] = (bf16)(vreg[i][e] >> 16); } }
    __syncthreads();
#pragma unroll
    for (int i = 0; i < 8; ++i) { const int idx = i * 512 + F.tid, d = idx >> 4, chk = idx & 15;
        *(u32x4*)(KT + d * 128 + 8 * chk) = *(const LAS u32x4*)(TK + d * TR_P + 8 * chk); *(u32x4*)(VT + d * 128 + 8 * chk) = *(const LAS u32x4*)(TV + d * TR_P + 8 * chk); }
    __syncthreads();
}
constexpr int KT_P = 136, RT_P = 264;
constexpr int RS_KT = 0, RS_VT = 256 * KT_P * 2, RS_RT = RS_VT + 32 * KT_P * 2, RS_END = RS_RT + 32 * RT_P * 2;
static_assert(RS_END <= LDS_BYTES, "retention scan LDS");
__device__ __forceinline__ void ret_scan_unit(Frame& F, int ru) {
    const int bh = ru >> 3, es = ru & 7, b = bh >> 2, h = bh & 3, e0 = 32 * es;
    const bf16* HB = (const bf16*)(F.ws + WS_HB); bf16* MIX = (bf16*)(F.ws + WS_MIX);
    LAS bf16* KT = (LAS bf16*)(F.lds + RS_KT); LAS bf16* VT = (LAS bf16*)(F.lds + RS_VT); LAS bf16* RT = (LAS bf16*)(F.lds + RS_RT);
    const float lg = ret_lg2gamma(h); const float g128 = exp2f(128.f * lg);
    const int w = F.wave, lane = F.lane, cl = lane & 15, dq = lane >> 4;
    const bf16* KTg = (const bf16*)(F.ws + WS_KT) + (size_t)bh * 128 * 32768; const bf16* VTg = (const bf16*)(F.ws + WS_VT) + (size_t)bh * 128 * 32768;
    for (int i = F.tid; i < 32 * RT_P / 2; i += 512) ((LAS unsigned*)RT)[i] = 0u;
    pg8::f32x4 acc[2][2];
#pragma unroll
    for (int i = 0; i < 2; ++i)
#pragma unroll
        for (int j = 0; j < 2; ++j) acc[i][j] = (pg8::f32x4){0.f, 0.f, 0.f, 0.f};
    u32x4 kreg[8], vreg, qreg[8];
    const size_t mb = (size_t)b * T;
#define RS_LOAD(n) do { const size_t r0_ = mb + (size_t)(n) * 128; \
        _Pragma("unroll") for (int i_ = 0; i_ < 8; ++i_) { const int idx_ = i_ * 512 + F.tid; kreg[i_] = *(const u32x4*)(KTg + (size_t)(n) * 32768 + (idx_ >> 4) * 128 + 8 * (idx_ & 15)); } \
        vreg = *(const u32x4*)(VTg + (size_t)(n) * 32768 + (e0 + (F.tid >> 4)) * 128 + 8 * (F.tid & 15)); \
        _Pragma("unroll") for (int k_ = 0; k_ < 8; ++k_) qreg[k_] = *(const u32x4*)(HB + (r0_ + 16 * w + cl) * NB + h * 256 + 32 * k_ + dq * 8); } while (0)
    RS_LOAD(0);
    for (int n = 0; n < T / 128; ++n) {
#pragma unroll
        for (int i = 0; i < 8; ++i) { const int idx = i * 512 + F.tid; *(LAS u32x4*)(KT + (idx >> 4) * KT_P + 8 * (idx & 15)) = kreg[i]; }
        *(LAS u32x4*)(VT + (F.tid >> 4) * KT_P + 8 * (F.tid & 15)) = vreg;
        __syncthreads();
        bf16x8 qcur[8];
#pragma unroll
        for (int k_ = 0; k_ < 8; ++k_) qcur[k_] = __builtin_bit_cast(bf16x8, qreg[k_]);
        if (n + 1 < T / 128) RS_LOAD(n + 1);
        { pg8::f32x4 cx[2] = {(pg8::f32x4){0.f, 0.f, 0.f, 0.f}, (pg8::f32x4){0.f, 0.f, 0.f, 0.f}};
#pragma unroll
          for (int ks = 0; ks < 8; ++ks)
#pragma unroll
              for (int et = 0; et < 2; ++et) { const bf16x8 Bf = *(const LAS bf16x8*)(RT + (16 * et + cl) * RT_P + 32 * ks + dq * 8);
                  cx[et] = __builtin_amdgcn_mfma_f32_16x16x32_bf16(qcur[ks], Bf, cx[et], 0, 0, 0); }
#pragma unroll
          for (int r = 0; r < 4; ++r) { const int c = 16 * w + dq * 4 + r; const float qd = exp2f((float)(c + 1) * lg);
#pragma unroll
              for (int et = 0; et < 2; ++et) MIX[(mb + (size_t)n * 128 + c) * D + DR + h * 256 + e0 + 16 * et + cl] = (bf16)f2bf(cx[et][r] * qd); } }
#pragma unroll
        for (int dt = 0; dt < 2; ++dt)
#pragma unroll
            for (int et = 0; et < 2; ++et) acc[dt][et] = acc[dt][et] * g128;
#pragma unroll
        for (int kc = 0; kc < 4; ++kc) { bf16x8 Af[2], Bf[2];
#pragma unroll
            for (int dt = 0; dt < 2; ++dt) Af[dt] = *(const LAS bf16x8*)(KT + (32 * w + 16 * dt + cl) * KT_P + 32 * kc + dq * 8);
#pragma unroll
            for (int et = 0; et < 2; ++et) Bf[et] = *(const LAS bf16x8*)(VT + (16 * et + cl) * KT_P + 32 * kc + dq * 8);
#pragma unroll
            for (int dt = 0; dt < 2; ++dt)
#pragma unroll
                for (int et = 0; et < 2; ++et) acc[dt][et] = __builtin_amdgcn_mfma_f32_16x16x32_bf16(Af[dt], Bf[et], acc[dt][et], 0, 0, 0); }
        __syncthreads();
#pragma unroll
        for (int dt = 0; dt < 2; ++dt)
#pragma unroll
            for (int et = 0; et < 2; ++et) { u32x2 p; p.x = pk2(acc[dt][et][0], acc[dt][et][1]); p.y = pk2(acc[dt][et][2], acc[dt][et][3]);
                *(LAS u32x2*)(RT + (16 * et + cl) * RT_P + 32 * w + 16 * dt + dq * 4) = p; }
    }
#undef RS_LOAD
    __syncthreads();
}
constexpr int KS_P = 264, VT_P = 136, PW_P = 136;
constexpr int RI_KS = 0, RI_VT = 128 * KS_P * 2, RI_END = RI_VT + 256 * VT_P * 2;
static_assert(RI_END <= LDS_BYTES && 8 * 16 * PW_P * 2 <= RI_VT, "retention intra LDS");
__device__ __forceinline__ void ret_intra_unit(Frame& F, const Args& a, int unit) {
    const int n = unit & 127, bh = unit >> 7, b = bh >> 2, h = bh & 3;
    const bf16* HB = (const bf16*)(F.ws + WS_HB); bf16* MIX = (bf16*)(F.ws + WS_MIX);
    LAS bf16* KS = (LAS bf16*)(F.lds + RI_KS); LAS bf16* VT = (LAS bf16*)(F.lds + RI_VT);
    const int w = F.wave, lane = F.lane, cl = lane & 15, dq = lane >> 4;
    const float lg = ret_lg2gamma(h);
    const size_t r0 = (size_t)b * T + (size_t)n * 128;
#pragma unroll
    for (int i = 0; i < 8; ++i) { const int idx = i * 512 + F.tid, c = idx >> 5, chk = idx & 31;
        *(LAS u32x4*)(KS + c * KS_P + 8 * chk) = *(const u32x4*)(HB + (r0 + c) * NB + 1024 + h * 256 + 8 * chk); }
    { const bf16* VTg = (const bf16*)(F.ws + WS_VT) + (size_t)unit * 32768;
#pragma unroll
      for (int i = 0; i < 8; ++i) { const int idx = i * 512 + F.tid, e = idx >> 4, chk = idx & 15; *(LAS u32x4*)(VT + e * VT_P + 8 * chk) = *(const u32x4*)(VTg + e * 128 + 8 * chk); } }
    bf16x8 qf[8];
#pragma unroll
    for (int ks = 0; ks < 8; ++ks) qf[ks] = __builtin_bit_cast(bf16x8, *(const u32x4*)(HB + (r0 + 16 * w + cl) * NB + h * 256 + 32 * ks + dq * 8));
    __syncthreads();
    pg8::f32x4 s[8];
#pragma unroll
    for (int mt = 0; mt < 8; ++mt) { s[mt] = (pg8::f32x4){0.f, 0.f, 0.f, 0.f};
        if (mt <= w) {
#pragma unroll
            for (int ks = 0; ks < 8; ++ks) { const bf16x8 Bf = *(const LAS bf16x8*)(KS + (16 * mt + cl) * KS_P + 32 * ks + dq * 8);
                s[mt] = __builtin_amdgcn_mfma_f32_16x16x32_bf16(qf[ks], Bf, s[mt], 0, 0, 0); } } }
    __syncthreads();
    LAS bf16* PW = (LAS bf16*)(F.lds) + w * 16 * PW_P;
#pragma unroll
    for (int mt = 0; mt < 8; ++mt)
#pragma unroll
        for (int r = 0; r < 4; ++r) { const int cc = 16 * w + dq * 4 + r, mm = 16 * mt + cl; const float dm = (mm <= cc) ? exp2f((float)(cc - mm) * lg) : 0.f;
            PW[(dq * 4 + r) * PW_P + mm] = (bf16)f2bf(s[mt][r] * dm); }
    LDS_WAIT(); asm volatile("" ::: "memory");
    pg8::f32x4 o[16];
#pragma unroll
    for (int et = 0; et < 16; ++et) o[et] = (pg8::f32x4){0.f, 0.f, 0.f, 0.f};
#pragma unroll
    for (int kc = 0; kc < 4; ++kc) if (kc <= (w >> 1)) { const bf16x8 Af = *(const LAS bf16x8*)(PW + cl * PW_P + 32 * kc + dq * 8);
#pragma unroll
        for (int et = 0; et < 16; ++et) { const bf16x8 Bf = *(const LAS bf16x8*)(VT + (16 * et + cl) * VT_P + 32 * kc + dq * 8);
            o[et] = __builtin_amdgcn_mfma_f32_16x16x32_bf16(Af, Bf, o[et], 0, 0, 0); } }
    const float* gnw = a.in[13] + h * 256;
#pragma unroll
    for (int r = 0; r < 4; ++r) { const size_t row = r0 + 16 * w + dq * 4 + r; bf16* mp = MIX + row * D + DR + h * 256 + cl; const bf16* gp = HB + row * NB + 3072 + h * 256 + cl;
        float sum = 0.f;
#pragma unroll
        for (int et = 0; et < 16; ++et) { o[et][r] += bf1(mp[16 * et]); sum += o[et][r]; }
        const float mean = row16_sum(sum) * (1.f / 256.f); float q = 0.f;
#pragma unroll
        for (int et = 0; et < 16; ++et) { const float d = o[et][r] - mean; q += d * d; }
        const float rstd = 1.f / sqrtf(row16_sum(q) * (1.f / 256.f) + RET_GN_EPS);
#pragma unroll
        for (int et = 0; et < 16; ++et) { const float g = bf1(gp[16 * et]); const float y = (o[et][r] - mean) * rstd * gnw[16 * et + cl] * (g * sigmoidf_(g)); mp[16 * et] = (bf16)f2bf(y); } }
    __syncthreads();
}
__device__ __forceinline__ void rwkv_finalize(Frame& F, const Args& a) {
    const Prep P = prep_ptrs(F); bf16* MIX = (bf16*)(F.ws + WS_MIX); const f16b* G = (const f16b*)(F.ws + WS_G);
    const int c0 = 16 * F.lane, hd = F.lane >> 2;
    float gw_[16], gb_[16];
#pragma unroll
    for (int j = 0; j < 4; ++j) { const f32x4 x = *(const f32x4*)(a.in[11] + c0 + 4 * j), y = *(const f32x4*)(a.in[12] + c0 + 4 * j);
        gw_[4 * j] = x.x; gw_[4 * j + 1] = x.y; gw_[4 * j + 2] = x.z; gw_[4 * j + 3] = x.w; gb_[4 * j] = y.x; gb_[4 * j + 1] = y.y; gb_[4 * j + 2] = y.z; gb_[4 * j + 3] = y.w; }
    for (int m = F.gw; m < M; m += F.NGW) {
        u32x4 yv[2], vv[2], gv[2];
        yv[0] = *(const u32x4*)(MIX + (size_t)m * D + c0); yv[1] = *(const u32x4*)(MIX + (size_t)m * D + c0 + 8);
        vv[0] = *(const u32x4*)(P.v + (size_t)m * DR + c0); vv[1] = *(const u32x4*)(P.v + (size_t)m * DR + c0 + 8);
        gv[0] = *(const u32x4*)(G + (size_t)m * DR + c0); gv[1] = *(const u32x4*)(G + (size_t)m * DR + c0 + 8);
        const float bon = P.bon[(size_t)m * 16 + hd];
        float y[16]; float s = 0.f;
#pragma unroll
        for (int j = 0; j < 8; ++j) { y[2 * j] = bf_lo(yv[j >> 2][j & 3]); y[2 * j + 1] = bf_hi(yv[j >> 2][j & 3]); s += y[2 * j] + y[2 * j + 1]; }
        s += __shfl_xor(s, 1); s += __shfl_xor(s, 2); const float mean = s * (1.f / 64.f); float q = 0.f;
#pragma unroll
        for (int j = 0; j < 16; ++j) { y[j] -= mean; q += y[j] * y[j]; }
        q += __shfl_xor(q, 1); q += __shfl_xor(q, 2); const float rstd = 1.f / sqrtf(q * (1.f / 64.f) + RWKV_GN_EPS);
        u32x4 ov[2];
#pragma unroll
        for (int j = 0; j < 8; ++j) { const unsigned vw = vv[j >> 2][j & 3], gw2 = gv[j >> 2][j & 3];
            const float o0 = (y[2 * j] * rstd * gw_[2 * j] + gb_[2 * j] + bon * h_lo(vw)) * h_lo(gw2);
            const float o1 = (y[2 * j + 1] * rstd * gw_[2 * j + 1] + gb_[2 * j + 1] + bon * h_hi(vw)) * h_hi(gw2);
            ov[j >> 2][j & 3] = pk2(o0, o1); }
        *(u32x4*)(MIX + (size_t)m * D + c0) = ov[0]; *(u32x4*)(MIX + (size_t)m * D + c0 + 8) = ov[1];
    }
}

constexpr int N_PHASES = 12;
__global__ void __launch_bounds__(NWAVES * 64, 2) fwd_kernel(Args args) {
    extern __shared__ __attribute__((aligned(16))) unsigned char lds_raw[];
    Frame F;
    F.lds = (LAS unsigned char*)lds_raw; F.ws = args.ws; F.out = args.out;
    F.tid = threadIdx.x; F.lane = F.tid & 63; F.wave = __builtin_amdgcn_readfirstlane(F.tid >> 6);
    F.G = gridDim.x; F.gw = blockIdx.x * NWAVES + F.wave; F.NGW = F.G * NWAVES;
    const int lo = args.ph_lo, hi = args.ph_hi;
#define IN(k) (lo <= (k) && (k) < hi)
    unsigned nbar = 0u; unsigned* gctr = (unsigned*)(args.ws + WS_CTL) + 128;
    volatile LAS unsigned* xst = (volatile LAS unsigned*)(F.lds + LDS_BYTES - 64);
    if (F.tid < 16) xst[F.tid] = 0u;
    __syncthreads();
    XcdBarrier xbar = xcd_barrier_post((unsigned*)(args.ws + WS_CTL) + 2048, xst);
#define SEAM(k) do { if (IN(k) && IN((k) + 1)) { if (args.coop == 1) { xcd_barrier(xbar); } else if (args.coop == 3) { nbar += (unsigned)F.G; sub_barrier(gctr, nbar); } else if (args.coop == 2) cg::this_grid().sync(); } } while (0)
    typedef pg8::bf16_t b16;
    if (IN(0)) { p0_prologue(F, args); } SEAM(0);
    if (IN(1)) {
        pg8::Gemm g{(const b16*)(F.ws + WS_XB), (const b16*)(F.ws + WS_WIN), M, N1A, D}; pg8::StaticOrder S; S.init(M, N1A, F.G, (int)blockIdx.x);
        pg8::EpiH16<0> E{(b16*)(F.ws + WS_HA), (b16*)(F.ws + WS_HB), (b16*)(F.ws + WS_HB), NA, NB, NB, NA, 1 << 30};
        pg8::gemm_phase<pg8::EpiH16<0>, pg8::StaticOrder, true, true>(F.lds, g, S, E);
    } SEAM(1);
    if (IN(2)) { p2a_prep(F, args); } SEAM(2);
    if (IN(3)) {
        pg8::Gemm g{(const b16*)((unsigned char*)F.out + OUT_AP), (const b16*)(F.ws + WS_WL), M, 3072, args.klora}; pg8::StaticOrder S; S.init(M, 3072, F.G, (int)blockIdx.x);
        pg8::EpiH16<2> E{(b16*)(F.ws + WS_LRW), (b16*)(F.ws + WS_LRA), (b16*)(F.ws + WS_G), DR, DR, DR, 1024, 2048};
        pg8::gemm_phase<pg8::EpiH16<2>, pg8::StaticOrder, true, true>(F.lds, g, S, E);
    } SEAM(3);
    if (IN(4)) { p2c_rwkv_prep(F, args); } SEAM(4);
    if (IN(5)) {
        if (blockIdx.x < 128) { rwkv_scan_unit(F, (int)blockIdx.x); }
        else {
            const int bb = (int)blockIdx.x - 128; unsigned* ctr = (unsigned*)(F.ws + WS_CTL) + 64;
            {
                pg8::Gemm g{(const b16*)(F.ws + WS_XB), (const b16*)(F.ws + WS_WIN) + (size_t)N1A * D, M, 6400 - N1A, D}; pg8::StaticOrder S; S.init(M, 6400 - N1A, 128, bb);
                pg8::EpiH16<0> E{(b16*)(F.ws + WS_HB) + (N1A - NA), (b16*)(F.ws + WS_HB), (b16*)(F.ws + WS_HB), NB, NB, NB, 1 << 30, 1 << 30};
                pg8::gemm_phase<pg8::EpiH16<0>, pg8::StaticOrder, true, true>(F.lds, g, S, E);
            }
            sub_barrier(ctr, 128u);
            ret_rotary(F, bb * NWAVES + F.wave, 128 * NWAVES);
            sub_barrier(ctr, 256u);
            for (int u = bb; u < 1024; u += 128) ret_transpose_unit(F, u);
            sub_barrier(ctr, 384u);
            if (bb < 64) ret_scan_unit(F, bb);
            else {
                p0_late_weights(F, args, (bb - 64) * NWAVES + F.wave, 64 * NWAVES);
                __syncthreads();
                pg8::Gemm g{(const b16*)(F.ws + WS_XB), (const b16*)(F.ws + WS_WIN) + (size_t)6400 * D, M, 1024, D}; pg8::StaticOrder S; S.init(M, 1024, 64, bb - 64);
                pg8::EpiH16<0> E{(b16*)(F.ws + WS_HB) + 3072, (b16*)(F.ws + WS_HB), (b16*)(F.ws + WS_HB), NB, NB, NB, 1 << 30, 1 << 30};
                pg8::gemm_phase<pg8::EpiH16<0>, pg8::StaticOrder, true, true>(F.lds, g, S, E);
            }
            sub_barrier(ctr, 512u);
        }
    }
    if (IN(5)) { if (blockIdx.x >= 128) { for (int u = (int)blockIdx.x - 128; u < 1024; u += 128) ret_intra_unit(F, args, u); } } SEAM(5);
    if (IN(6)) { rwkv_finalize(F, args); } SEAM(6);
    if (IN(7)) {
        pg8::Gemm g{(const b16*)(F.ws + WS_MIX), (const b16*)(F.ws + WS_WO), M, D, D}; pg8::StaticOrder S; S.init(M, D, F.G, (int)blockIdx.x);
        pg8::EpiH16<0> E{(b16*)(F.ws + WS_HB), (b16*)(F.ws + WS_HB), (b16*)(F.ws + WS_HB), D, D, D, 1 << 30, 1 << 30};
        pg8::gemm_phase<pg8::EpiH16<0>, pg8::StaticOrder, true, true>(F.lds, g, S, E);
    } SEAM(7);
    if (IN(8)) { ln_pass<false>(F, args.in[0], (const bf16*)(F.ws + WS_HB), nullptr, (bf16*)(F.ws + WS_X1B), args.in[15], args.in[16]); } SEAM(8);
    if (IN(9)) {
        pg8::Gemm g{(const b16*)(F.ws + WS_X1B), (const b16*)(F.ws + WS_WUP), M, DFF, D}; pg8::StaticOrder S; S.init(M, DFF, F.G, (int)blockIdx.x);
        pg8::EpiH16<1> E{(b16*)(F.ws + WS_U), (b16*)(F.ws + WS_U), (b16*)(F.ws + WS_U), DFF, DFF, DFF, 1 << 30, 1 << 30};
        pg8::gemm_phase<pg8::EpiH16<1>, pg8::StaticOrder, true, true>(F.lds, g, S, E);
    } SEAM(9);
    if (IN(10)) {
        pg8::Gemm g{(const b16*)(F.ws + WS_U), (const b16*)(F.ws + WS_WDN), M, D, DFF}; pg8::StaticOrder S; S.init(M, D, F.G, (int)blockIdx.x);
        pg8::EpiH16<0> E{(b16*)(F.ws + WS_KT), (b16*)(F.ws + WS_KT), (b16*)(F.ws + WS_KT), D, D, D, 1 << 30, 1 << 30};
        pg8::gemm_phase<pg8::EpiH16<0>, pg8::StaticOrder, true, true>(F.lds, g, S, E);
    } SEAM(10);
    if (IN(11)) { ln_pass<true>(F, (const bf16*)(F.ws + WS_X1B), (const bf16*)(F.ws + WS_KT), F.out, nullptr, args.in[19], args.in[20]); }
#undef IN
#undef SEAM
}

extern "C" void kernel_launch(void* const* d_in, const int* in_sizes, int n_in, void* d_out, int out_size, void* d_ws, size_t ws_size, hipStream_t stream) {
    static int grid = 0;
    if (grid == 0) {
        if (n_in != 21 || in_sizes[0] != M * D || out_size != M * D || ws_size < WS_END) { fprintf(stderr, "kernel_launch: unexpected shapes: n_in %d in0 %d out %d ws %zu\n", n_in, n_in > 0 ? in_sizes[0] : -1, out_size, ws_size); grid = -1; return; }
        int dev = 0, cus = 0;
        if (hipGetDevice(&dev) != hipSuccess || hipDeviceGetAttribute(&cus, hipDeviceAttributeMultiprocessorCount, dev) != hipSuccess) { grid = -1; return; }
        if (hipFuncSetAttribute((const void*)fwd_kernel, hipFuncAttributeMaxDynamicSharedMemorySize, LDS_BYTES) != hipSuccess) { fprintf(stderr, "kernel_launch: hipFuncSetAttribute failed\n"); grid = -1; return; }
        (void)hipGetLastError();
        if (cus < 256) { fprintf(stderr, "kernel_launch: this kernel splits phase 5 over exactly 256 co-resident workgroups; device has %d CUs\n", cus); grid = -1; return; }
        grid = 256;
    }
    if (grid < 0) return;
    (void)hipMemsetAsync(d_ws, 0, 32768, stream);
    Args a{};
    for (int i = 0; i < 21; ++i) a.in[i] = (const float*)d_in[i];
    a.out = (float*)d_out; a.ws = (unsigned char*)d_ws; a.klora = NLORA;
    a.ph_lo = 0; a.ph_hi = N_PHASES; a.coop = 1;
    void* kargs[] = {&a};
    hipError_t e = hipLaunchCooperativeKernel((const void*)fwd_kernel, dim3(grid), dim3(NWAVES * 64), kargs, LDS_BYTES, stream);
    if (e != hipSuccess) fprintf(stderr, "kernel_launch: cooperative launch failed: %s (grid %d)\n", hipGetErrorString(e), grid);
}
```

```cpp
#include <hip/hip_runtime.h>
#include <hip/hip_cooperative_groups.h>
#include <cstdio>
#include <cstdint>
namespace cg = cooperative_groups;
namespace pg8 {
#define PG8_LAS __attribute__((address_space(3)))
typedef unsigned short bf16_t;
typedef short bf16x8 __attribute__((ext_vector_type(8)));
typedef float f32x4 __attribute__((ext_vector_type(4)));
typedef unsigned u32x4 __attribute__((ext_vector_type(4)));
constexpr int BM = 256, BK = 64, HALF = 128, HTB = HALF * BK * 2  , STAGE_BYTES = 8 * HTB, NXCD = 8, WGM = 8;

__host__ __device__ __forceinline__ int lds_byte(int r, int c) { const int st = (r >> 4) * 2 + (c >> 5), rr = r & 15, cc = c & 31, ob = rr * 64 + cc * 2; return st * 1024 + (ob ^ (((ob >> 9) & 1) << 5)); }
__host__ __device__ __forceinline__ void stage_rc(int b, int& R, int& C) { const int st = b / 1024, sb = b % 1024, swz = sb ^ (((sb >> 9) & 1) << 5); R = (st >> 1) * 16 + swz / 64; C = (st & 1) * 32 + (swz % 64) / 2; }
__host__ __device__ __forceinline__ int perm32(int rho) { const int n = rho >> 4, i = rho & 15; return 8 * (i >> 2) + 4 * n + (i & 3); }

struct Unit { int pm, pn; };
struct Gemm { const bf16_t* A; const bf16_t* Bt; int M, N, K; };

struct StaticOrder {
    int nM, nN, nwg, G, c;
    __host__ __device__ void init(int M, int N, int G_, int c_) { nM = M / BM; nN = N / BM; nwg = nM * nN; G = G_; c = c_; }
    __host__ __device__ bool next(int i, Unit& u) const {
        const long L = (long)i * G + c; if (L >= nwg) return false;
        int wgid = (int)L; { const int q = nwg / NXCD, r = nwg % NXCD, xcd = wgid % NXCD, off = wgid / NXCD; wgid = (xcd < r ? xcd * (q + 1) : r * (q + 1) + (xcd - r) * q) + off; }
        const int nig = WGM * nN, gid = wgid / nig, fm = gid * WGM, gsz = (nM - fm) < WGM ? (nM - fm) : WGM;
        u.pm = fm + ((wgid % nig) % gsz); u.pn = (wgid % nig) / gsz; return true;
    }
    __device__ __forceinline__ void a_ready(const Unit&) const {}
    __device__ __forceinline__ void done(const Unit&) const {}
};

__device__ __forceinline__ unsigned cvt_pk_bf16(float lo, float hi) { unsigned r; asm volatile("v_cvt_pk_bf16_f32 %0, %1, %2" : "=v"(r) : "v"(lo), "v"(hi)); return r; }
typedef _Float16 f16x2_t __attribute__((ext_vector_type(2)));
__device__ __forceinline__ unsigned cvt_pk_f16(float lo, float hi) { f16x2_t v; v.x = (_Float16)lo; v.y = (_Float16)hi; return __builtin_bit_cast(unsigned, v); }
template <int MODE> struct EpiH16 {
    static constexpr bool PERM = true, AFTER_DRAIN = false;
    bf16_t* O0; bf16_t* O1; bf16_t* O2; int ld0, ld1, ld2, split0, split1;
    __device__ __forceinline__ void operator()(const f32x4 (&acc)[2][2][4][2], const Unit& u, int wr, int wc, int fr, int fq) const {
        const int row0 = u.pm * BM + wr * 64 + fr; int colt = u.pn * BM; bf16_t* base = O0; int ldc = ld0;
        if (colt >= split1) { base = O2; ldc = ld2; colt -= split1; } else if (colt >= split0) { base = O1; ldc = ld1; colt -= split0; }
        const int col0 = colt + wc * 32 + 8 * fq;
#pragma unroll
        for (int ai = 0; ai < 2; ++ai)
#pragma unroll
            for (int m = 0; m < 4; ++m) { bf16_t* rowp = base + (size_t)(row0 + ai * HALF + m * 16) * ldc + col0;
#pragma unroll
                for (int bj = 0; bj < 2; ++bj) { f32x4 v0 = acc[ai][bj][m][0], v1 = acc[ai][bj][m][1];
                    if (MODE == 1) {
#pragma unroll
                        for (int e = 0; e < 4; ++e) { float a = fmaxf(v0[e], 0.f), b = fmaxf(v1[e], 0.f); v0[e] = a * a; v1[e] = b * b; } }
                    u32x4 w;
                    if (MODE == 2) { w.x = cvt_pk_f16(v0[0], v0[1]); w.y = cvt_pk_f16(v0[2], v0[3]); w.z = cvt_pk_f16(v1[0], v1[1]); w.w = cvt_pk_f16(v1[2], v1[3]); }
                    else { w.x = cvt_pk_bf16(v0[0], v0[1]); w.y = cvt_pk_bf16(v0[2], v0[3]); w.z = cvt_pk_bf16(v1[0], v1[1]); w.w = cvt_pk_bf16(v1[2], v1[3]); }
                    *(u32x4*)(rowp + bj * HALF) = w; } }
    }
};
struct EpiResid {
    static constexpr bool PERM = false, AFTER_DRAIN = false;
    const float* base; float* out; int ldc; float alpha;
    __device__ __forceinline__ void operator()(const f32x4 (&acc)[2][2][4][2], const Unit& u, int wr, int wc, int fr, int fq) const {
        const int row0 = u.pm * BM + wr * 64 + fr, col0 = u.pn * BM + wc * 32 + 4 * fq;
#pragma unroll
        for (int ai = 0; ai < 2; ++ai)
#pragma unroll
            for (int m = 0; m < 4; ++m) { const size_t off = (size_t)(row0 + ai * HALF + m * 16) * ldc + col0;
#pragma unroll
                for (int bj = 0; bj < 2; ++bj)
#pragma unroll
                    for (int n = 0; n < 2; ++n) { const size_t p = off + bj * HALF + n * 16; const f32x4 b = *(const f32x4*)(base + p); *(f32x4*)(out + p) = b * alpha + acc[ai][bj][m][n]; } }
    }
};
template <class Epi, class Sched, bool ALIGN_EPI = false, bool SP2 = false>
__device__ __forceinline__ void gemm_phase(PG8_LAS unsigned char* lds, const Gemm g, const Sched& S, const Epi& E) {
    const int tid = threadIdx.x, wid = __builtin_amdgcn_readfirstlane(tid >> 6), lane = tid & 63, wr = wid >> 2, wc = wid & 3, fr = lane & 15, fq = lane >> 4;
    const int K = g.K, nt = K / BK;
    unsigned voffA[2], voffB[2];
#pragma unroll
    for (int i = 0; i < 2; ++i) { int R, C; stage_rc(tid * 16 + i * 8192, R, C); const int Rb = Epi::PERM ? ((R & ~31) + perm32(R & 31)) : R;
        voffA[i] = (unsigned)(R * K + C) * 2u; voffB[i] = (unsigned)(Rb * K + C) * 2u; }
    const size_t kstep = (size_t)(BK * 2);
    const size_t hstep = (size_t)HALF * K * 2;
    const size_t tstep = 2 * hstep;
    const unsigned ldsw = (unsigned)wid * 1024u;
    const int aoff = lds_byte(wr * 64 + fr, fq * 8), boff = lds_byte(wc * 32 + fr, fq * 8);
#define PG8_SA(b, h) (((b) * 2 + (h)) * HTB)
#define PG8_SB(b, h) ((4 + (b) * 2 + (h)) * HTB)
#define PG8_STAGE(bufoff, gbase, voff) do { _Pragma("unroll") for (int _i = 0; _i < 2; ++_i) \
        __builtin_amdgcn_global_load_lds((const unsigned*)((const char*)(gbase) + (voff)[_i]), (PG8_LAS unsigned*)(lds + (bufoff) + ldsw + _i * 8192), 16, 0, 0); } while (0)
#define PG8_LDA(dst, b, h) do { _Pragma("unroll") for (int m = 0; m < 4; ++m) _Pragma("unroll") for (int k = 0; k < 2; ++k) dst[m][k] = *(const PG8_LAS bf16x8*)(lds + PG8_SA(b, h) + aoff + m * 2048 + k * 1024); } while (0)
#define PG8_LDB(dst, b, h) do { _Pragma("unroll") for (int n = 0; n < 2; ++n) _Pragma("unroll") for (int k = 0; k < 2; ++k) dst[n][k] = *(const PG8_LAS bf16x8*)(lds + PG8_SB(b, h) + boff + n * 2048 + k * 1024); } while (0)
#define PG8_MMA(ai, bj, At, Bt) do { __builtin_amdgcn_s_setprio(1); _Pragma("unroll") for (int m = 0; m < 4; ++m) _Pragma("unroll") for (int n = 0; n < 2; ++n) _Pragma("unroll") for (int k = 0; k < 2; ++k) \
        acc[ai][bj][m][n] = __builtin_amdgcn_mfma_f32_16x16x32_bf16(Bt[n][k], At[m][k], acc[ai][bj][m][n], 0, 0, 0); __builtin_amdgcn_s_setprio(0); } while (0)
#define PG8_WAIT_V(n) asm volatile("s_waitcnt vmcnt(" #n ")" ::: "memory")
#define PG8_WAIT_L(n) asm volatile("s_waitcnt lgkmcnt(" #n ")" ::: "memory")
#define PG8_BAR __builtin_amdgcn_s_barrier()
#define PG8_SCHED __builtin_amdgcn_sched_barrier(0)
    Unit cur, nxt; int ui = 0;
    if (!S.next(0, cur)) return;
    f32x4 acc[2][2][4][2];
#pragma unroll
    for (int a = 0; a < 2; ++a)
#pragma unroll
        for (int b = 0; b < 2; ++b)
#pragma unroll
            for (int m = 0; m < 4; ++m)
#pragma unroll
                for (int n = 0; n < 2; ++n) acc[a][b][m][n] = (f32x4){0.f, 0.f, 0.f, 0.f};
    bf16x8 At[4][2], B0[2][2], B1[2][2];
    const char* cA = (const char*)g.A + (size_t)cur.pm * tstep; const char* cB = (const char*)g.Bt + (size_t)cur.pn * tstep;
    S.a_ready(cur);
    if constexpr (SP2) {
        PG8_STAGE(PG8_SB(0, 0), cB, voffB); PG8_STAGE(PG8_SB(0, 1), cB + hstep, voffB); PG8_STAGE(PG8_SA(0, 0), cA, voffA); PG8_STAGE(PG8_SA(0, 1), cA + hstep, voffA);
        if (wr == 1) PG8_BAR;
        PG8_WAIT_V(2); PG8_BAR;
        PG8_STAGE(PG8_SB(1, 0), cB + kstep, voffB); PG8_STAGE(PG8_SA(1, 0), cA + kstep, voffA); PG8_STAGE(PG8_SB(1, 1), cB + hstep + kstep, voffB);
        PG8_WAIT_V(6); PG8_BAR;
    } else {
        PG8_STAGE(PG8_SB(0, 0), cB, voffB); PG8_STAGE(PG8_SA(0, 0), cA, voffA); PG8_STAGE(PG8_SB(0, 1), cB + hstep, voffB); PG8_STAGE(PG8_SA(0, 1), cA + hstep, voffA);
        if (wr == 1) PG8_BAR;
        PG8_WAIT_V(4); PG8_BAR;
        PG8_STAGE(PG8_SB(1, 0), cB + kstep, voffB); PG8_STAGE(PG8_SA(1, 0), cA + kstep, voffA); PG8_STAGE(PG8_SB(1, 1), cB + hstep + kstep, voffB);
        PG8_WAIT_V(6); PG8_BAR;
    }
    for (;;) {
        const bool has_next = S.next(ui + 1, nxt);
        const char* nA = has_next ? (const char*)g.A + (size_t)nxt.pm * tstep : cA; const char* nB = has_next ? (const char*)g.Bt + (size_t)nxt.pn * tstep : cB;
        for (int t = 0; t < nt; t += 2) {
            const bool last = (t == nt - 2);
            const char* a1 = cA + (size_t)(t + 1) * kstep;
            const char* a2 = last ? nA : cA + (size_t)(t + 2) * kstep; const char* b2 = last ? nB : cB + (size_t)(t + 2) * kstep;
            const char* a3 = a2 + kstep; const char* b3 = b2 + kstep;
            if (last && has_next) S.a_ready(nxt);
            if constexpr (SP2) {
            PG8_LDB(B0, 0, 0); PG8_LDB(B1, 0, 1); PG8_SCHED; PG8_LDA(At, 0, 0); PG8_STAGE(PG8_SA(1, 1), a1 + hstep, voffA);
            PG8_WAIT_V(8); PG8_WAIT_L(0); PG8_BAR; PG8_MMA(0, 0, At, B0); PG8_MMA(0, 1, At, B1); PG8_BAR; PG8_SCHED;
            PG8_LDA(At, 0, 1); PG8_STAGE(PG8_SB(0, 0), b2, voffB); PG8_STAGE(PG8_SB(0, 1), b2 + hstep, voffB); PG8_STAGE(PG8_SA(0, 0), a2, voffA);
            PG8_WAIT_V(8); PG8_WAIT_L(0); PG8_BAR; PG8_MMA(1, 0, At, B0); PG8_MMA(1, 1, At, B1); PG8_BAR; PG8_SCHED;
            PG8_LDB(B0, 1, 0); PG8_LDB(B1, 1, 1); PG8_SCHED; PG8_LDA(At, 1, 0); PG8_STAGE(PG8_SA(0, 1), a2 + hstep, voffA);
            PG8_WAIT_V(8); PG8_WAIT_L(0); PG8_BAR; PG8_MMA(0, 0, At, B0); PG8_MMA(0, 1, At, B1); PG8_BAR; PG8_SCHED;
            PG8_LDA(At, 1, 1); PG8_STAGE(PG8_SB(1, 0), b3, voffB); PG8_STAGE(PG8_SB(1, 1), b3 + hstep, voffB); PG8_STAGE(PG8_SA(1, 0), a3, voffA);
            PG8_WAIT_V(8); PG8_WAIT_L(0); PG8_BAR; PG8_MMA(1, 0, At, B0); PG8_MMA(1, 1, At, B1); PG8_BAR; PG8_SCHED;
            } else {
            PG8_LDB(B0, 0, 0); PG8_SCHED; PG8_LDA(At, 0, 0); PG8_STAGE(PG8_SA(1, 1), a1 + hstep, voffA);
            PG8_WAIT_L(8); PG8_BAR; PG8_WAIT_L(0); PG8_MMA(0, 0, At, B0); PG8_BAR; PG8_SCHED;
            PG8_LDB(B1, 0, 1); PG8_STAGE(PG8_SB(0, 0), b2, voffB);
            PG8_BAR; PG8_WAIT_L(0); PG8_MMA(0, 1, At, B1); PG8_BAR;
            PG8_LDA(At, 0, 1); PG8_STAGE(PG8_SA(0, 0), a2, voffA);
            PG8_BAR; PG8_WAIT_L(0); PG8_MMA(1, 0, At, B0); PG8_BAR; PG8_SCHED;
            PG8_STAGE(PG8_SB(0, 1), b2 + hstep, voffB);
            PG8_WAIT_V(6); PG8_BAR; PG8_MMA(1, 1, At, B1); PG8_BAR;
            PG8_LDB(B0, 1, 0); PG8_SCHED; PG8_LDA(At, 1, 0); PG8_STAGE(PG8_SA(0, 1), a2 + hstep, voffA);
            PG8_WAIT_L(8); PG8_BAR; PG8_WAIT_L(0); PG8_MMA(0, 0, At, B0); PG8_BAR; PG8_SCHED;
            PG8_LDB(B1, 1, 1); PG8_STAGE(PG8_SB(1, 0), b3, voffB);
            PG8_BAR; PG8_WAIT_L(0); PG8_MMA(0, 1, At, B1); PG8_BAR;
            PG8_LDA(At, 1, 1); PG8_STAGE(PG8_SA(1, 0), a3, voffA);
            PG8_BAR; PG8_WAIT_L(0); PG8_MMA(1, 0, At, B0); PG8_BAR; PG8_SCHED;
            PG8_STAGE(PG8_SB(1, 1), b3 + hstep, voffB);
            PG8_WAIT_V(6); PG8_BAR; PG8_MMA(1, 1, At, B1); PG8_BAR;
            }
        }
        if constexpr (ALIGN_EPI) { if (wr == 0) PG8_BAR; }
        if constexpr (!Epi::AFTER_DRAIN) { E(acc, cur, wr, wc, fr, fq); S.done(cur); }
        if (!has_next) break;
#pragma unroll
        for (int a = 0; a < 2; ++a)
#pragma unroll
            for (int b = 0; b < 2; ++b)
#pragma unroll
                for (int m = 0; m < 4; ++m)
#pragma unroll
                    for (int n = 0; n < 2; ++n) acc[a][b][m][n] = (f32x4){0.f, 0.f, 0.f, 0.f};
        cur = nxt; cA = nA; cB = nB; ++ui;
        if constexpr (ALIGN_EPI) { if (wr == 1) PG8_BAR; }
    }
    PG8_WAIT_V(0);
    if constexpr (!ALIGN_EPI) { if (wr == 0) PG8_BAR; }
    PG8_BAR;
    if constexpr (Epi::AFTER_DRAIN) { E.fused(acc, cur, wr, wc, fr, fq, lds, wid, lane); S.done(cur); }
#undef PG8_SA
#undef PG8_SB
#undef PG8_STAGE
#undef PG8_LDA
#undef PG8_LDB
#undef PG8_MMA
#undef PG8_WAIT_V
#undef PG8_WAIT_L
#undef PG8_BAR
#undef PG8_SCHED
}
}
constexpr int NWAVES = 8;
constexpr int BATCH = 2, T = 16384, M = BATCH * T, D = 2048, NIN = 7424, DFF = 8192;
constexpr int NA = 3328, NB = 4096;
constexpr int DR = 1024;
constexpr int NLORA = 256;
constexpr float LN_EPS = 1e-5f, RWKV_GN_EPS = 64e-5f, RET_GN_EPS = 1e-6f;
constexpr float ALPHA = 1.189207115002721f;
constexpr size_t MiB = 1u << 20;
constexpr size_t WS_CTL = 0, WS_WL = 1 * MiB, WS_BON = 3 * MiB, WS_WIN = 8 * MiB, WS_WO = 38 * MiB, WS_WUP = 46 * MiB, WS_WDN = 78 * MiB;
constexpr size_t WS_XB = 112 * MiB;
constexpr size_t WS_HA = 240 * MiB, WS_MIX = 240 * MiB, WS_HB = 448 * MiB;
constexpr size_t WS_G = 704 * MiB, WS_P5 = 768 * MiB, WS_P6 = 832 * MiB, WS_LRW = 896 * MiB, WS_LRA = 960 * MiB, WS_END = 1024 * MiB;
constexpr size_t WS_U = 240 * MiB, WS_X1B = 768 * MiB;
constexpr size_t OUT_AP = 0;
static_assert(WS_HA + (size_t)M * NA * 2 <= WS_HB && WS_HB + (size_t)M * NB * 2 <= WS_G && WS_U + (size_t)M * DFF * 2 <= WS_X1B, "ws map");
constexpr int N1A = NA + 256;
constexpr int LDS_BYTES = 163840;
#define LAS __attribute__((address_space(3)))
typedef unsigned short bf16;
typedef unsigned short f16b;
typedef float f32x4 __attribute__((ext_vector_type(4)));
typedef float f32x2 __attribute__((ext_vector_type(2)));
typedef unsigned u32x4 __attribute__((ext_vector_type(4)));
typedef unsigned u32x2 __attribute__((ext_vector_type(2)));
typedef short bf16x8 __attribute__((ext_vector_type(8)));
typedef _Float16 h16x2 __attribute__((ext_vector_type(2)));
typedef _Float16 h16x8 __attribute__((ext_vector_type(8)));
#define LDS_WAIT() asm volatile("s_waitcnt lgkmcnt(0)" ::: "memory")

__device__ __forceinline__ unsigned f2bf(float f) { unsigned u = __builtin_bit_cast(unsigned, f); return (u + 0x7fffu + ((u >> 16) & 1u)) >> 16; }
__device__ __forceinline__ unsigned pk2(float lo, float hi) { return f2bf(lo) | (f2bf(hi) << 16); }
__device__ __forceinline__ float bf_lo(unsigned w) { return __builtin_bit_cast(float, w << 16); }
__device__ __forceinline__ float bf_hi(unsigned w) { return __builtin_bit_cast(float, w & 0xffff0000u); }
__device__ __forceinline__ float bf1(bf16 v) { return __builtin_bit_cast(float, (unsigned)v << 16); }
__device__ __forceinline__ unsigned pkh(float lo, float hi) { h16x2 v; v.x = (_Float16)lo; v.y = (_Float16)hi; return __builtin_bit_cast(unsigned, v); }
__device__ __forceinline__ float h_lo(unsigned w) { h16x2 v = __builtin_bit_cast(h16x2, w); return (float)v.x; }
__device__ __forceinline__ float h_hi(unsigned w) { h16x2 v = __builtin_bit_cast(h16x2, w); return (float)v.y; }
__device__ __forceinline__ float wave_sum(float v) {
#pragma unroll
    for (int o = 1; o < 64; o <<= 1) v += __shfl_xor(v, o);
    return v;
}
template <int CTRL> __device__ __forceinline__ float dpp_mov(float x) { return __builtin_bit_cast(float, __builtin_amdgcn_update_dpp(0, __builtin_bit_cast(int, x), CTRL, 0xF, 0xF, true)); }
__device__ __forceinline__ float row16_sum(float x) { x += dpp_mov<0x128>(x); x += dpp_mov<0x124>(x); x += dpp_mov<0x122>(x); x += dpp_mov<0x121>(x); return x; }
__device__ __forceinline__ float fma_s(float a, float b, float c) { float d; asm("v_fma_f32 %0, %1, %2, %3" : "=v"(d) : "v"(a), "v"(b), "v"(c)); return d; }
__device__ __forceinline__ float fnma_s(float a, float b, float c) { float d; asm("v_fma_f32 %0, -%1, %2, %3" : "=v"(d) : "v"(a), "v"(b), "v"(c)); return d; }
__device__ __forceinline__ float mul_s(float a, float b) { float d; asm("v_mul_f32 %0, %1, %2" : "=v"(d) : "v"(a), "v"(b)); return d; }
__device__ __forceinline__ float sigmoidf_(float x) { return 1.f / (1.f + __expf(-x)); }

struct Args { const float* in[21]; float* out; unsigned char* ws; int ph_lo, ph_hi, coop, klora, reps, pad; };
struct Frame {
    LAS unsigned char* lds; unsigned char* ws; float* out;
    int tid, lane, wave, G, gw, NGW;
};

__device__ __forceinline__ void p0_transpose_item(const float* W, int K, int N, bf16* WT, LAS float* scr, int item, int lane, bool remap) {
    const int nblk = N / 32, kb = item / nblk, nb = item % nblk, k0 = 64 * kb, n0 = 32 * nb;
    const int nd = !remap ? n0 : (n0 < NA ? n0 : (n0 >= 6400 ? n0 - 6400 + NA : n0 + 1024));
#pragma unroll 32
    for (int i = 0; i < 32; ++i) { const int kk = 2 * i + (lane >> 5); scr[kk * 33 + (lane & 31)] = W[(size_t)(k0 + kk) * N + n0 + (lane & 31)]; }
    LDS_WAIT(); asm volatile("" ::: "memory");
    const int c = lane & 7;
#pragma unroll
    for (int j = 0; j < 4; ++j) { const int n = (lane >> 3) + 8 * j; const LAS float* s = scr + (8 * c) * 33 + n;
        u32x4 o; o.x = pk2(s[0 * 33], s[1 * 33]); o.y = pk2(s[2 * 33], s[3 * 33]); o.z = pk2(s[4 * 33], s[5 * 33]); o.w = pk2(s[6 * 33], s[7 * 33]);
        *(u32x4*)(WT + (size_t)(nd + n) * K + k0 + 8 * c) = o; }
    LDS_WAIT(); asm volatile("" ::: "memory");
}
__device__ __forceinline__ void p0_late_weights(Frame& F, const Args& a, int w, int nw) {
    LAS float* scr = (LAS float*)(F.lds + F.wave * 16384);
    const float *w_o = a.in[14], *w_up = a.in[17], *w_dn = a.in[18];
    bf16 *WO = (bf16*)(F.ws + WS_WO), *WUP = (bf16*)(F.ws + WS_WUP), *WDN = (bf16*)(F.ws + WS_WDN);
    constexpr int I_O = (D / 64) * (D / 32), I_UP = (D / 64) * (DFF / 32), I_DN = (DFF / 64) * (D / 32);
    for (int it = w; it < I_O + I_UP + I_DN; it += nw) {
        int r = it;
        if (r < I_O) { p0_transpose_item(w_o, D, D, WO, scr, r, F.lane, false); continue; } r -= I_O;
        if (r < I_UP) { p0_transpose_item(w_up, D, DFF, WUP, scr, r, F.lane, false); continue; } r -= I_UP;
        p0_transpose_item(w_dn, DFF, D, WDN, scr, r, F.lane, false);
    }
}
__device__ __forceinline__ void p0_prologue(Frame& F, const Args& a) {
    LAS float* scr = (LAS float*)(F.lds + F.wave * 16384);
    { const float* w_in = a.in[1]; bf16* WIN = (bf16*)(F.ws + WS_WIN);
      constexpr int I_IN = (D / 64) * (NIN / 32);
      for (int it = F.gw; it < I_IN; it += F.NGW) p0_transpose_item(w_in, D, NIN, WIN, scr, it, F.lane, false); }
    const int gt = F.gw * 64 + F.lane, NGT = F.NGW * 64;
    { bf16* WL = (bf16*)(F.ws + WS_WL); const float *wl = a.in[4], *al = a.in[6], *gl = a.in[7];
      for (int idx = gt; idx < 3072 * NLORA; idx += NGT) { const int n = idx >> 8, k = idx & 255; float v = 0.f;
          if (n < 1024) { if (k < 64) v = wl[k * 1024 + n]; }
          else if (n < 2048) { if (k >= 64 && k < 128) v = al[(k - 64) * 1024 + (n - 1024)]; }
          else { if (k >= 128) v = gl[(k - 128) * 1024 + (n - 2048)]; }
          WL[idx] = (bf16)f2bf(v); } }
    { const float* x = a.in[0]; bf16* XB = (bf16*)(F.ws + WS_XB);
      for (size_t c = gt; c < (size_t)M * D / 8; c += (size_t)4 * NGT) { f32x4 v0[4], v1[4];
#pragma unroll
          for (int q = 0; q < 4; ++q) { const size_t cc = c + (size_t)q * NGT; v0[q] = *(const f32x4*)(x + cc * 8); v1[q] = *(const f32x4*)(x + cc * 8 + 4); }
#pragma unroll
          for (int q = 0; q < 4; ++q) { const size_t cc = c + (size_t)q * NGT; u32x4 o; o.x = pk2(v0[q].x, v0[q].y); o.y = pk2(v0[q].z, v0[q].w); o.z = pk2(v1[q].x, v1[q].y); o.w = pk2(v1[q].z, v1[q].w); *(u32x4*)(XB + cc * 8) = o; } } }
}

template <bool IN16> __device__ __forceinline__ void ln_pass(Frame& F, const void* in, const bf16* add, float* out, bf16* outb, const float* w, const float* b) {
    for (int m0 = 2 * F.gw; m0 < M; m0 += 2 * F.NGW) {
        f32x4 v[2][8]; u32x2 av[2][8], iv[2][8]; float s[2] = {0.f, 0.f};
#pragma unroll
        for (int r = 0; r < 2; ++r) { const u32x2* ar = (const u32x2*)(add + (size_t)(m0 + r) * D) + F.lane;
#pragma unroll
            for (int j = 0; j < 8; ++j) { av[r][j] = __builtin_nontemporal_load(ar + 64 * j);
                if (IN16) iv[r][j] = __builtin_nontemporal_load((const u32x2*)((const bf16*)in + (size_t)(m0 + r) * D) + F.lane + 64 * j);
                else v[r][j] = __builtin_nontemporal_load((const f32x4*)((const float*)in + (size_t)(m0 + r) * D) + F.lane + 64 * j); } }
#pragma unroll
        for (int r = 0; r < 2; ++r) {
#pragma unroll
            for (int j = 0; j < 8; ++j) { if (IN16) v[r][j] = (f32x4){bf_lo(iv[r][j].x), bf_hi(iv[r][j].x), bf_lo(iv[r][j].y), bf_hi(iv[r][j].y)};
                v[r][j] = v[r][j] * ALPHA + (f32x4){bf_lo(av[r][j].x), bf_hi(av[r][j].x), bf_lo(av[r][j].y), bf_hi(av[r][j].y)}; s[r] += (v[r][j].x + v[r][j].y) + (v[r][j].z + v[r][j].w); }
            const float mean = wave_sum(s[r]) * (1.f / D); float s2 = 0.f;
#pragma unroll
            for (int j = 0; j < 8; ++j) { v[r][j] = v[r][j] - mean; s2 += (v[r][j].x * v[r][j].x + v[r][j].y * v[r][j].y) + (v[r][j].z * v[r][j].z + v[r][j].w * v[r][j].w); }
            const float rstd = 1.f / sqrtf(wave_sum(s2) * (1.f / D) + LN_EPS);
#pragma unroll
            for (int j = 0; j < 8; ++j) { const f32x4 wv = ((const f32x4*)w)[64 * j + F.lane], bv = ((const f32x4*)b)[64 * j + F.lane];
                const f32x4 q = v[r][j] * rstd * wv + bv;
                if (out) __builtin_nontemporal_store(q, (f32x4*)(out + (size_t)(m0 + r) * D) + F.lane + 64 * j);
                if (outb) { u32x2 p; p.x = pk2(q.x, q.y); p.y = pk2(q.z, q.w); __builtin_nontemporal_store(p, (u32x2*)(outb + (size_t)(m0 + r) * D) + 64 * j + F.lane); } }
        }
    }
}

__device__ __forceinline__ void p2a_prep(Frame& F, const Args& a) {
    const bf16* HA = (const bf16*)(F.ws + WS_HA); bf16* AP = (bf16*)((unsigned char*)F.out + OUT_AP);
    const int j0 = 4 * F.lane; const f32x4 mu4 = *(const f32x4*)(a.in[2] + 3072 + j0);
#pragma unroll 2
    for (int m = F.gw; m < M; m += F.NGW) {
        const int t = m & (T - 1);
        const u32x2 cur = *(const u32x2*)(HA + (size_t)m * NA + 3072 + j0); u32x2 prv = (u32x2){0u, 0u};
        if (t > 0) prv = *(const u32x2*)(HA + (size_t)(m - 1) * NA + 3072 + j0);
        float c[4] = {bf_lo(cur.x), bf_hi(cur.x), bf_lo(cur.y), bf_hi(cur.y)}, p[4] = {bf_lo(prv.x), bf_hi(prv.x), bf_lo(prv.y), bf_hi(prv.y)};
        const float mu[4] = {mu4.x, mu4.y, mu4.z, mu4.w}; float f[4];
#pragma unroll
        for (int e = 0; e < 4; ++e) { float v = c[e] + (p[e] - c[e]) * mu[e];
            if (F.lane < 16) v = 1.f - 2.f / (1.f + __expf(2.f * v));
            else if (F.lane >= 32) v = sigmoidf_(v);
            f[e] = v; }
        u32x2 o; o.x = pk2(f[0], f[1]); o.y = pk2(f[2], f[3]); *(u32x2*)(AP + (size_t)m * NLORA + j0) = o;
    }
}
__device__ __forceinline__ void ret_rotary(Frame& F, int w, int nw) {
    bf16* HB = (bf16*)(F.ws + WS_HB);
    const float if0 = 1.0f / exp2f((float)F.lane * (13.287712379549449f / 127.0f)), if1 = 1.0f / exp2f((float)(64 + F.lane) * (13.287712379549449f / 127.0f));
    for (int m = w; m < M; m += nw) {
        const int t = m & (T - 1);
        const float th0 = (float)t * if0, th1 = (float)t * if1;
        const double r0 = (double)th0 * 0.15915494309189535, r1 = (double)th1 * 0.15915494309189535;
        const float f0 = (float)(r0 - __builtin_rint(r0)), f1 = (float)(r1 - __builtin_rint(r1));
        const float c0 = __builtin_amdgcn_cosf(f0), s0 = __builtin_amdgcn_sinf(f0), c1 = __builtin_amdgcn_cosf(f1), s1 = __builtin_amdgcn_sinf(f1);
        unsigned qv[8], kv[8];
#pragma unroll
        for (int it = 0; it < 8; ++it) { const int p = it * 64 + F.lane, hd = p >> 7, i = p & 127;
            qv[it] = *(const unsigned*)(HB + (size_t)m * NB + hd * 256 + 2 * i); kv[it] = *(const unsigned*)(HB + (size_t)m * NB + 1024 + hd * 256 + 2 * i); }
#pragma unroll
        for (int it = 0; it < 8; ++it) { const int p = it * 64 + F.lane, hd = p >> 7, i = p & 127; const float cs = (it & 1) ? c1 : c0, sn = (it & 1) ? s1 : s0;
            const float q1 = bf_lo(qv[it]), q2 = bf_hi(qv[it]), k1 = bf_lo(kv[it]), k2 = bf_hi(kv[it]);
            *(unsigned*)(HB + (size_t)m * NB + hd * 256 + 2 * i) = pk2(q1 * cs - q2 * sn, q1 * sn + q2 * cs);
            *(unsigned*)(HB + (size_t)m * NB + 1024 + hd * 256 + 2 * i) = pk2((k1 * cs - k2 * sn) * 0.0625f, (k1 * sn + k2 * cs) * 0.0625f); }
    }
}
#define XB_TMO      128
#define XB_XCNT(j)  (256  + 64 * (j))
#define XB_XSUB(j)  (1280 + 64 * (j))
#define XB_XGEN(j)  (2304 + 64 * (j))
#define XB_TOP      3328
#define XB_TOPGEN   3392
#define XCD_BAR_WORDS 3456
#define XB_SPIN_CAP (1u << 18)

__device__ __forceinline__ unsigned xb_ld(unsigned* p)              { return __hip_atomic_load(p, __ATOMIC_RELAXED, __HIP_MEMORY_SCOPE_AGENT); }
__device__ __forceinline__ unsigned xb_add(unsigned* p, unsigned v) { return __hip_atomic_fetch_add(p, v, __ATOMIC_RELAXED, __HIP_MEMORY_SCOPE_AGENT); }
__device__ __forceinline__ unsigned xb_xcc_id() { return (unsigned)__builtin_amdgcn_s_getreg((3 << 11) | 20) & 0xFu; }
#define XB_SPIN(cond, bar) do { unsigned _sp = 0; while (cond) { __builtin_amdgcn_s_sleep(1); \
    if ((++_sp & 255u) == 0u) { if (xb_ld(&(bar)[XB_TMO])) break; if (_sp > XB_SPIN_CAP) { atomicAdd(&(bar)[XB_TMO], 1u); break; } } } } while (0)

struct XcdBarrier {
    unsigned* bar; unsigned x;
    volatile LAS unsigned* st;
};

__device__ __forceinline__ XcdBarrier xcd_barrier_post(unsigned* bar, volatile LAS unsigned* st) {
    XcdBarrier b; b.bar = bar; b.x = xb_xcc_id(); b.st = st;
    if (threadIdx.x == 0) (void)xb_add(&bar[XB_XCNT(b.x)], 1u);
    return b;
}
__device__ __forceinline__ void xcd_barrier_complete(unsigned* bar, unsigned x, unsigned& nloc, unsigned& nx) {
    const unsigned G = gridDim.x * gridDim.y * gridDim.z;
    unsigned sum, cnt, mine, sp = 0u;
    for (;;) {
        sum = 0u; cnt = 0u; mine = 0u;
#pragma unroll
        for (unsigned j = 0; j < 16; ++j) { const unsigned c = xb_ld(&bar[XB_XCNT(j)]); sum += c; cnt += (c > 0u) ? 1u : 0u; mine = (j == x) ? c : mine; }
        if (sum == G) break;
        __builtin_amdgcn_s_sleep(1);
        if ((++sp & 255u) == 0u) { if (xb_ld(&bar[XB_TMO])) break; if (sp > XB_SPIN_CAP) { atomicAdd(&bar[XB_TMO], 1u); break; } }
    }
    nloc = mine > 0u ? mine : 1u; nx = cnt > 0u ? cnt : 1u;
}

__device__ __forceinline__ void xcd_barrier(const XcdBarrier& b) {
    asm volatile("s_waitcnt vmcnt(0)" ::: "memory");
    __syncthreads();
    if (threadIdx.x == 0) {
        unsigned* bar = b.bar;
        __builtin_amdgcn_s_waitcnt(0);
        unsigned nloc = b.st[0], nx = b.st[1];
        if (nloc == 0u) { xcd_barrier_complete(bar, b.x, nloc, nx); b.st[0] = nloc; b.st[1] = nx; }
        const unsigned old = xb_add(&bar[XB_XSUB(b.x)], 1u);
        const unsigned gen = old / nloc;
        if (old + 1u == (gen + 1u) * nloc) {
            __builtin_amdgcn_fence(__ATOMIC_RELEASE, "agent");
            asm volatile("s_waitcnt vmcnt(0)" ::: "memory");
            const unsigned og = xb_add(&bar[XB_TOP], 1u);
            const unsigned tg = og / nx;
            if (og + 1u == (tg + 1u) * nx) xb_add(&bar[XB_TOPGEN], 1u);
            else XB_SPIN(xb_ld(&bar[XB_TOPGEN]) == tg, bar);
            __builtin_amdgcn_fence(__ATOMIC_ACQUIRE, "agent");
            xb_add(&bar[XB_XGEN(b.x)], 1u);
            asm volatile("s_waitcnt vmcnt(0)" ::: "memory");
        } else {
            XB_SPIN(xb_ld(&bar[XB_XGEN(b.x)]) == gen, bar);
            __builtin_amdgcn_fence(__ATOMIC_ACQUIRE, "agent");
            asm volatile("s_waitcnt vmcnt(0)" ::: "memory");
        }
    }
    __syncthreads();
}

__device__ __forceinline__ void sub_barrier(unsigned* ctr, unsigned target) {
    asm volatile("s_waitcnt vmcnt(0)" ::: "memory");
    __syncthreads();
    if (threadIdx.x == 0) {
        __builtin_amdgcn_fence(__ATOMIC_RELEASE, "agent");
        asm volatile("s_waitcnt vmcnt(0)" ::: "memory");
        __hip_atomic_fetch_add(ctr, 1u, __ATOMIC_RELAXED, __HIP_MEMORY_SCOPE_AGENT);
        while (__hip_atomic_load(ctr, __ATOMIC_RELAXED, __HIP_MEMORY_SCOPE_AGENT) < target) __builtin_amdgcn_s_sleep(2);
        __builtin_amdgcn_fence(__ATOMIC_ACQUIRE, "agent");
        asm volatile("s_waitcnt vmcnt(0)" ::: "memory");
    }
    __syncthreads();
}

struct Prep { f16b *r, *x, *km, *v, *kk, *b; float* bon; };
__device__ __forceinline__ Prep prep_ptrs(Frame& F) { Prep p; f16b* o = (f16b*)F.out; const size_t S = (size_t)M * DR;
    p.r = o; p.x = o + S; p.km = o + 2 * S; p.v = o + 3 * S; p.kk = (f16b*)(F.ws + WS_P5); p.b = (f16b*)(F.ws + WS_P6); p.bon = (float*)(F.ws + WS_BON); return p; }
__device__ __forceinline__ void p2c_rwkv_prep(Frame& F, const Args& a) {
    const bf16* HA = (const bf16*)(F.ws + WS_HA); const f16b* LRW = (const f16b*)(F.ws + WS_LRW); const f16b* LRA = (const f16b*)(F.ws + WS_LRA);
    const Prep P = prep_ptrs(F);
    const int qd = F.gw & 3, c0 = 256 * qd + 4 * F.lane, hd = c0 >> 6;
    const f32x4 mu_r = *(const f32x4*)(a.in[2] + c0), mu_k = *(const f32x4*)(a.in[2] + 1024 + c0), mu_v = *(const f32x4*)(a.in[2] + 2048 + c0);
    const f32x4 w0 = *(const f32x4*)(a.in[3] + c0), a0 = *(const f32x4*)(a.in[5] + c0), k_k = *(const f32x4*)(a.in[8] + c0), k_a = *(const f32x4*)(a.in[9] + c0), r_k = *(const f32x4*)(a.in[10] + c0);
    const int NI = F.NGW >> 2;
#pragma unroll 4
    for (int m = F.gw >> 2; m < M; m += NI) {
        const int t = m & (T - 1); const bf16* row = HA + (size_t)m * NA + c0; const size_t o = (size_t)m * DR + c0;
        const u32x2 cr = *(const u32x2*)(row), ck = *(const u32x2*)(row + 1024), cv = *(const u32x2*)(row + 2048);
        u32x2 pr = (u32x2){0u, 0u}, pk = pr, pv = pr;
        if (t > 0) { pr = *(const u32x2*)(row - NA); pk = *(const u32x2*)(row - NA + 1024); pv = *(const u32x2*)(row - NA + 2048); }
        const u32x2 lw = *(const u32x2*)(LRW + o), la = *(const u32x2*)(LRA + o);
        float r[4], k[4], v[4], x[4], as[4], kk[4], km[4]; float n2 = 0.f, bon = 0.f;
#pragma unroll
        for (int e = 0; e < 4; ++e) {
            const unsigned wr_ = cr[e >> 1], wk_ = ck[e >> 1], wv_ = cv[e >> 1], qr_ = pr[e >> 1], qk_ = pk[e >> 1], qv_ = pv[e >> 1];
            const float hr = (e & 1) ? bf_hi(wr_) : bf_lo(wr_), hk = (e & 1) ? bf_hi(wk_) : bf_lo(wk_), hv = (e & 1) ? bf_hi(wv_) : bf_lo(wv_);
            const float gr = (e & 1) ? bf_hi(qr_) : bf_lo(qr_), gk = (e & 1) ? bf_hi(qk_) : bf_lo(qk_), gv = (e & 1) ? bf_hi(qv_) : bf_lo(qv_);
            r[e] = hr + (gr - hr) * mu_r[e]; k[e] = hk + (gk - hk) * mu_k[e]; v[e] = hv + (gv - hv) * mu_v[e];
            const float wpre = w0[e] + ((e & 1) ? h_hi(lw[e >> 1]) : h_lo(lw[e >> 1])), apre = a0[e] + ((e & 1) ? h_hi(la[e >> 1]) : h_lo(la[e >> 1]));
            const float z = -wpre; const float sp = fmaxf(z, 0.f) + __logf(1.f + __expf(-fabsf(z)));
            const float ew = __expf(-sp - 0.5f); x[e] = 1.f - __expf(-ew);
            as[e] = sigmoidf_(apre); kk[e] = k[e] * k_k[e]; n2 += kk[e] * kk[e];
            km[e] = k[e] * (1.f + (as[e] - 1.f) * k_a[e]); bon += r[e] * km[e] * r_k[e]; }
        n2 = row16_sum(n2); bon = row16_sum(bon);
        const float inv = 1.f / fmaxf(sqrtf(n2), 1e-12f);
#pragma unroll
        for (int e = 0; e < 4; ++e) kk[e] *= inv;
        *(u32x2*)(P.r + o) = (u32x2){pkh(r[0], r[1]), pkh(r[2], r[3])}; *(u32x2*)(P.x + o) = (u32x2){pkh(x[0], x[1]), pkh(x[2], x[3])};
        *(u32x2*)(P.km + o) = (u32x2){pkh(km[0], km[1]), pkh(km[2], km[3])}; *(u32x2*)(P.v + o) = (u32x2){pkh(v[0], v[1]), pkh(v[2], v[3])};
        *(u32x2*)(P.kk + o) = (u32x2){pkh(kk[0], kk[1]), pkh(kk[2], kk[3])}; *(u32x2*)(P.b + o) = (u32x2){pkh(kk[0] * as[0], kk[1] * as[1]), pkh(kk[2] * as[2], kk[3] * as[3])};
        if ((F.lane & 15) == 0) P.bon[(size_t)m * 16 + hd] = bon;
    }
}
constexpr int RC = 32;
constexpr int RB_VEC = 0, RB_SCL = 16 * 9 * 64, RB_V = RB_SCL + 16 * 12, RB_Y = RB_V + RC * 16, RB_FLOATS = RB_Y + RC * 256;
static_assert(2 * RB_FLOATS * 4 <= LDS_BYTES, "rwkv scan LDS");
__device__ __forceinline__ void rwkv_scan_unit(Frame& F, int unit) {
    const int bh = unit >> 2, rg = unit & 3, b = bh >> 4, h = bh & 15; const size_t m0 = (size_t)b * T; const int ch0 = h * 64;
    const Prep P = prep_ptrs(F); bf16* MIX = (bf16*)(F.ws + WS_MIX);
    LAS float* L = (LAS float*)F.lds;
    constexpr int NCH = T / RC;
    if (F.wave >= 4) {
        const int ht = F.tid - 256, pp = ht >> 4, c4 = (ht & 15) * 4, s = ht >> 3, c8 = ht & 7;
        u32x2 qr[2][2], qx[2][2], qk[2][2], qa[2][2], qb[2][2]; unsigned qv[2];
#define RW_LOAD(c, S_) do { \
        _Pragma("unroll") for (int u_ = 0; u_ < 2; ++u_) { const size_t o_ = (m0 + (size_t)(c) * RC + 2 * pp + u_) * DR + ch0 + c4; \
            qr[S_][u_] = *(const u32x2*)(P.r + o_); qx[S_][u_] = *(const u32x2*)(P.x + o_); qk[S_][u_] = *(const u32x2*)(P.km + o_); qa[S_][u_] = *(const u32x2*)(P.kk + o_); qb[S_][u_] = *(const u32x2*)(P.b + o_); } \
        qv[S_] = *(const unsigned*)(P.v + (m0 + (size_t)(c) * RC + s) * DR + ch0 + 16 * rg + 2 * c8); } while (0)
#define RW_WRITE(buf, S_) do { LAS float* B_ = L + (buf) * RB_FLOATS; float c1_ = 0.f, c2_ = 0.f, br0_ = 0.f, kr0_ = 0.f, d1_ = 0.f, d2_ = 0.f, br1_ = 0.f, kr1_ = 0.f; \
        f32x4 o_[9]; \
        _Pragma("unroll") for (int e_ = 0; e_ < 4; ++e_) { \
            const unsigned wr0u = qr[S_][0][e_ >> 1], wx0u = qx[S_][0][e_ >> 1], wk0u = qk[S_][0][e_ >> 1], wa0u = qa[S_][0][e_ >> 1], wb0u = qb[S_][0][e_ >> 1]; \
            const unsigned wr1u = qr[S_][1][e_ >> 1], wx1u = qx[S_][1][e_ >> 1], wk1u = qk[S_][1][e_ >> 1], wa1u = qa[S_][1][e_ >> 1], wb1u = qb[S_][1][e_ >> 1]; \
            const float r0 = (e_ & 1) ? h_hi(wr0u) : h_lo(wr0u), w0 = 1.f - ((e_ & 1) ? h_hi(wx0u) : h_lo(wx0u)), k0 = (e_ & 1) ? h_hi(wk0u) : h_lo(wk0u), a0 = (e_ & 1) ? h_hi(wa0u) : h_lo(wa0u), b0 = (e_ & 1) ? h_hi(wb0u) : h_lo(wb0u); \
            const float r1 = (e_ & 1) ? h_hi(wr1u) : h_lo(wr1u), w1 = 1.f - ((e_ & 1) ? h_hi(wx1u) : h_lo(wx1u)), k1 = (e_ & 1) ? h_hi(wk1u) : h_lo(wk1u), a1 = (e_ & 1) ? h_hi(wa1u) : h_lo(wa1u), b1 = (e_ & 1) ? h_hi(wb1u) : h_lo(wb1u); \
            const float wr1 = w1 * r1; \
            o_[0][e_] = a0; o_[1][e_] = w0 * r0; o_[2][e_] = w0 * a1; o_[3][e_] = w0 * wr1; o_[4][e_] = w0 * w1; o_[5][e_] = k0 * w1; o_[6][e_] = b0 * w1; o_[7][e_] = k1; o_[8][e_] = b1; \
            c1_ += b0 * a1; c2_ += k0 * a1; br0_ += b0 * r0; kr0_ += k0 * r0; d1_ += b0 * wr1; d2_ += k0 * wr1; br1_ += b1 * r1; kr1_ += k1 * r1; } \
        _Pragma("unroll") for (int j_ = 0; j_ < 9; ++j_) *(LAS f32x4*)(B_ + RB_VEC + (pp * 9 + j_) * 64 + c4) = o_[j_]; \
        c1_ = row16_sum(c1_); c2_ = row16_sum(c2_); br0_ = row16_sum(br0_); kr0_ = row16_sum(kr0_); d1_ = row16_sum(d1_); d2_ = row16_sum(d2_); br1_ = row16_sum(br1_); kr1_ = row16_sum(kr1_); \
        if ((ht & 15) == 0) { *(LAS f32x4*)(B_ + RB_SCL + pp * 12) = (f32x4){c1_, c2_, br0_ * 0.0625f, kr0_ * 0.0625f}; *(LAS f32x4*)(B_ + RB_SCL + pp * 12 + 4) = (f32x4){d1_ * 0.0625f, d2_ * 0.0625f, br1_ * 0.0625f, kr1_ * 0.0625f}; } \
        *(LAS f32x2*)(B_ + RB_V + s * 16 + 2 * c8) = (f32x2){h_lo(qv[S_]), h_hi(qv[S_])}; } while (0)
#define RW_STOREY(buf, c) do { const LAS float* B_ = L + (buf) * RB_FLOATS; float y_[2]; \
        _Pragma("unroll") for (int q_ = 0; q_ < 2; ++q_) { const LAS f32x4* yp_ = (const LAS f32x4*)(B_ + RB_Y + (s * 16 + 2 * c8 + q_) * 16); \
            const f32x4 a_ = yp_[0], b_ = yp_[1], c_ = yp_[2], d_ = yp_[3]; \
            y_[q_] = ((a_.x + a_.y) + (a_.z + a_.w)) + ((b_.x + b_.y) + (b_.z + b_.w)) + (((c_.x + c_.y) + (c_.z + c_.w)) + ((d_.x + d_.y) + (d_.z + d_.w))); } \
        *(unsigned*)(MIX + (m0 + (size_t)(c) * RC + s) * D + ch0 + 16 * rg + 2 * c8) = pk2(y_[0], y_[1]); } while (0)
        RW_LOAD(0, 0); RW_WRITE(0, 0); RW_LOAD(1, 1); RW_LOAD(2, 0);
        __syncthreads();
        for (int c = 0; c < NCH; c += 2) {
            if (c + 1 < NCH) RW_WRITE(1, 1);
            if (c + 3 < NCH) RW_LOAD(c + 3, 1);
            if (c > 0) RW_STOREY(1, c - 1);
            __syncthreads();
            if (c + 2 < NCH) RW_WRITE(0, 0);
            if (c + 4 < NCH) RW_LOAD(c + 4, 0);
            RW_STOREY(0, c);
            __syncthreads();
        }
        RW_STOREY((NCH - 1) & 1, NCH - 1);
#undef RW_LOAD
#undef RW_WRITE
#undef RW_STOREY
    } else {
        const int g4 = F.lane >> 4, l = F.lane & 15, vrow = F.wave * 4 + g4;
        f32x2 Sa = (f32x2){0.f, 0.f}, Sb = (f32x2){0.f, 0.f};
        struct PairV { f32x4 v[9]; f32x4 sa, sb; float vv0, vv1; };
#define SC_LD(d, p_) do { _Pragma("unroll") for (int j_ = 0; j_ < 9; ++j_) d.v[j_] = *(const LAS f32x4*)(B + RB_VEC + ((p_) * 9 + j_) * 64 + 4 * l); \
        d.sa = *(const LAS f32x4*)(B + RB_SCL + (p_) * 12); d.sb = *(const LAS f32x4*)(B + RB_SCL + (p_) * 12 + 4); d.vv0 = B[RB_V + (2 * (p_)) * 16 + vrow]; d.vv1 = B[RB_V + (2 * (p_) + 1) * 16 + vrow]; } while (0)
#define LO2(q_) ((f32x2){(q_).x, (q_).y})
#define HI2(q_) ((f32x2){(q_).z, (q_).w})
#define SC_PAIR(d, p_) do { \
        const f32x2 t1 = Sa * LO2(d.v[0]) + Sb * HI2(d.v[0]), t2 = Sa * LO2(d.v[1]) + Sb * HI2(d.v[1]), t3 = Sa * LO2(d.v[2]) + Sb * HI2(d.v[2]), t4 = Sa * LO2(d.v[3]) + Sb * HI2(d.v[3]); \
        const float p1 = row16_sum(t1.x + t1.y), r3 = row16_sum(t3.x + t3.y); \
        const float p1n = r3 - p1 * d.sa.x + d.vv0 * d.sa.y; \
        Y[(2 * (p_)) * 256 + vrow * 16 + l] = (t2.x + t2.y) + (d.vv0 * d.sa.w - p1 * d.sa.z); \
        Y[(2 * (p_) + 1) * 256 + vrow * 16 + l] = (t4.x + t4.y) + ((d.vv0 * d.sb.y - p1 * d.sb.x) + (d.vv1 * d.sb.w - p1n * d.sb.z)); \
        const f32x2 ea = (LO2(d.v[5]) * d.vv0 - LO2(d.v[6]) * p1) + (LO2(d.v[7]) * d.vv1 - LO2(d.v[8]) * p1n), eb = (HI2(d.v[5]) * d.vv0 - HI2(d.v[6]) * p1) + (HI2(d.v[7]) * d.vv1 - HI2(d.v[8]) * p1n); \
        Sa = Sa * LO2(d.v[4]) + ea; Sb = Sb * HI2(d.v[4]) + eb; } while (0)
        __syncthreads();
        for (int c = 0; c < NCH; ++c) {
            const LAS float* B = L + (c & 1) * RB_FLOATS; LAS float* Y = L + (c & 1) * RB_FLOATS + RB_Y;
            PairV a0, a1;
            SC_LD(a0, 0);
#pragma unroll
            for (int p = 0; p < RC / 2; p += 2) {
                SC_LD(a1, p + 1);
                SC_PAIR(a0, p);
                if (p + 2 < RC / 2) SC_LD(a0, p + 2);
                SC_PAIR(a1, p + 1);
            }
            __syncthreads();
        }
#undef SC_LD
#undef SC_PAIR
#undef LO2
#undef HI2
    }
}

constexpr size_t WS_KT = 896 * MiB, WS_VT = 960 * MiB;
constexpr int TR_P = 136;
static_assert(2 * 256 * TR_P * 2 <= LDS_BYTES, "transpose LDS");
__device__ __forceinline__ float ret_lg2gamma(int h) { return log2f(1.0f - exp2f(-5.0f - (float)h)); }
__device__ __forceinline__ void ret_transpose_unit(Frame& F, int unit) {
    const int n = unit & 127, bh = unit >> 7, b = bh >> 2, h = bh & 3;
    const bf16* HB = (const bf16*)(F.ws + WS_HB); bf16* KT = (bf16*)(F.ws + WS_KT) + (size_t)unit * 32768; bf16* VT = (bf16*)(F.ws + WS_VT) + (size_t)unit * 32768;
    LAS bf16* TK = (LAS bf16*)F.lds; LAS bf16* TV = TK + 256 * TR_P;
    const int w = F.wave, cl = F.lane & 15, dq = F.lane >> 4, c = 16 * w + cl;
    const float dk = exp2f((float)(127 - c) * ret_lg2gamma(h));
    const size_t r0 = (size_t)b * T + (size_t)n * 128;
    u32x4 kreg[8], vreg[8];
#pragma unroll
    for (int i = 0; i < 8; ++i) { kreg[i] = *(const u32x4*)(HB + (r0 + c) * NB + 1024 + h * 256 + (4 * i + dq) * 8); vreg[i] = *(const u32x4*)(HB + (r0 + c) * NB + 2048 + h * 256 + (4 * i + dq) * 8); }
#pragma unroll
    for (int i = 0; i < 8; ++i) { const int d0 = (4 * i + dq) * 8;
#pragma unroll
        for (int e = 0; e < 4; ++e) { TK[(d0 + 2 * e) * TR_P + c] = (bf16)f2bf(bf_lo(kreg[i][e]) * dk); TK[(d0 + 2 * e + 1) * TR_P + c] = (bf16)f2bf(bf_hi(kreg[i][e]) * dk);
            TV[(d0 + 2 * e) * TR_P + c] = (bf16)(vreg[i][e] & 0xffffu); TV[(d0 + 2 * e + 1) * TR_P + c] = (bf16)(vreg[i][e] >> 16); } }
    __syncthreads();
#pragma unroll
    for (int i = 0; i < 8; ++i) { const int idx = i * 512 + F.tid, d = idx >> 4, chk = idx & 15;
        *(u32x4*)(KT + d * 128 + 8 * chk) = *(const LAS u32x4*)(TK + d * TR_P + 8 * chk); *(u32x4*)(VT + d * 128 + 8 * chk) = *(const LAS u32x4*)(TV + d * TR_P + 8 * chk); }
    __syncthreads();
}
constexpr int KT_P = 136, RT_P = 264;
constexpr int RS_KT = 0, RS_VT = 256 * KT_P * 2, RS_RT = RS_VT + 32 * KT_P * 2, RS_END = RS_RT + 32 * RT_P * 2;
static_assert(RS_END <= LDS_BYTES, "retention scan LDS");
__device__ __forceinline__ void ret_scan_unit(Frame& F, int ru) {
    const int bh = ru >> 3, es = ru & 7, b = bh >> 2, h = bh & 3, e0 = 32 * es;
    const bf16* HB = (const bf16*)(F.ws + WS_HB); bf16* MIX = (bf16*)(F.ws + WS_MIX);
    LAS bf16* KT = (LAS bf16*)(F.lds + RS_KT); LAS bf16* VT = (LAS bf16*)(F.lds + RS_VT); LAS bf16* RT = (LAS bf16*)(F.lds + RS_RT);
    const float lg = ret_lg2gamma(h); const float g128 = exp2f(128.f * lg);
    const int w = F.wave, lane = F.lane, cl = lane & 15, dq = lane >> 4;
    const bf16* KTg = (const bf16*)(F.ws + WS_KT) + (size_t)bh * 128 * 32768; const bf16* VTg = (const bf16*)(F.ws + WS_VT) + (size_t)bh * 128 * 32768;
    for (int i = F.tid; i < 32 * RT_P / 2; i += 512) ((LAS unsigned*)RT)[i] = 0u;
    pg8::f32x4 acc[2][2];
#pragma unroll
    for (int i = 0; i < 2; ++i)
#pragma unroll
        for (int j = 0; j < 2; ++j) acc[i][j] = (pg8::f32x4){0.f, 0.f, 0.f, 0.f};
    u32x4 kreg[8], vreg, qreg[8];
    const size_t mb = (size_t)b * T;
#define RS_LOAD(n) do { const size_t r0_ = mb + (size_t)(n) * 128; \
        _Pragma("unroll") for (int i_ = 0; i_ < 8; ++i_) { const int idx_ = i_ * 512 + F.tid; kreg[i_] = *(const u32x4*)(KTg + (size_t)(n) * 32768 + (idx_ >> 4) * 128 + 8 * (idx_ & 15)); } \
        vreg = *(const u32x4*)(VTg + (size_t)(n) * 32768 + (e0 + (F.tid >> 4)) * 128 + 8 * (F.tid & 15)); \
        _Pragma("unroll") for (int k_ = 0; k_ < 8; ++k_) qreg[k_] = *(const u32x4*)(HB + (r0_ + 16 * w + cl) * NB + h * 256 + 32 * k_ + dq * 8); } while (0)
    RS_LOAD(0);
    for (int n = 0; n < T / 128; ++n) {
#pragma unroll
        for (int i = 0; i < 8; ++i) { const int idx = i * 512 + F.tid; *(LAS u32x4*)(KT + (idx >> 4) * KT_P + 8 * (idx & 15)) = kreg[i]; }
        *(LAS u32x4*)(VT + (F.tid >> 4) * KT_P + 8 * (F.tid & 15)) = vreg;
        __syncthreads();
        bf16x8 qcur[8];
#pragma unroll
        for (int k_ = 0; k_ < 8; ++k_) qcur[k_] = __builtin_bit_cast(bf16x8, qreg[k_]);
        if (n + 1 < T / 128) RS_LOAD(n + 1);
        { pg8::f32x4 cx[2] = {(pg8::f32x4){0.f, 0.f, 0.f, 0.f}, (pg8::f32x4){0.f, 0.f, 0.f, 0.f}};
#pragma unroll
          for (int ks = 0; ks < 8; ++ks)
#pragma unroll
              for (int et = 0; et < 2; ++et) { const bf16x8 Bf = *(const LAS bf16x8*)(RT + (16 * et + cl) * RT_P + 32 * ks + dq * 8);
                  cx[et] = __builtin_amdgcn_mfma_f32_16x16x32_bf16(qcur[ks], Bf, cx[et], 0, 0, 0); }
#pragma unroll
          for (int r = 0; r < 4; ++r) { const int c = 16 * w + dq * 4 + r; const float qd = exp2f((float)(c + 1) * lg);
#pragma unroll
              for (int et = 0; et < 2; ++et) MIX[(mb + (size_t)n * 128 + c) * D + DR + h * 256 + e0 + 16 * et + cl] = (bf16)f2bf(cx[et][r] * qd); } }
#pragma unroll
        for (int dt = 0; dt < 2; ++dt)
#pragma unroll
            for (int et = 0; et < 2; ++et) acc[dt][et] = acc[dt][et] * g128;
#pragma unroll
        for (int kc = 0; kc < 4; ++kc) { bf16x8 Af[2], Bf[2];
#pragma unroll
            for (int dt = 0; dt < 2; ++dt) Af[dt] = *(const LAS bf16x8*)(KT + (32 * w + 16 * dt + cl) * KT_P + 32 * kc + dq * 8);
#pragma unroll
            for (int et = 0; et < 2; ++et) Bf[et] = *(const LAS bf16x8*)(VT + (16 * et + cl) * KT_P + 32 * kc + dq * 8);
#pragma unroll
            for (int dt = 0; dt < 2; ++dt)
#pragma unroll
                for (int et = 0; et < 2; ++et) acc[dt][et] = __builtin_amdgcn_mfma_f32_16x16x32_bf16(Af[dt], Bf[et], acc[dt][et], 0, 0, 0); }
        __syncthreads();
#pragma unroll
        for (int dt = 0; dt < 2; ++dt)
#pragma unroll
            for (int et = 0; et < 2; ++et) { u32x2 p; p.x = pk2(acc[dt][et][0], acc[dt][et][1]); p.y = pk2(acc[dt][et][2], acc[dt][et][3]);
                *(LAS u32x2*)(RT + (16 * et + cl) * RT_P + 32 * w + 16 * dt + dq * 4) = p; }
    }
#undef RS_LOAD
    __syncthreads();
}
constexpr int KS_P = 264, VT_P = 136, PW_P = 136;
constexpr int RI_KS = 0, RI_VT = 128 * KS_P * 2, RI_END = RI_VT + 256 * VT_P * 2;
static_assert(RI_END <= LDS_BYTES && 8 * 16 * PW_P * 2 <= RI_VT, "retention intra LDS");
__device__ __forceinline__ void ret_intra_unit(Frame& F, const Args& a, int unit) {
    const int n = unit & 127, bh = unit >> 7, b = bh >> 2, h = bh & 3;
    const bf16* HB = (const bf16*)(F.ws + WS_HB); bf16* MIX = (bf16*)(F.ws + WS_MIX);
    LAS bf16* KS = (LAS bf16*)(F.lds + RI_KS); LAS bf16* VT = (LAS bf16*)(F.lds + RI_VT);
    const int w = F.wave, lane = F.lane, cl = lane & 15, dq = lane >> 4;
    const float lg = ret_lg2gamma(h);
    const size_t r0 = (size_t)b * T + (size_t)n * 128;
#pragma unroll
    for (int i = 0; i < 8; ++i) { const int idx = i * 512 + F.tid, c = idx >> 5, chk = idx & 31;
        *(LAS u32x4*)(KS + c * KS_P + 8 * chk) = *(const u32x4*)(HB + (r0 + c) * NB + 1024 + h * 256 + 8 * chk); }
    { const bf16* VTg = (const bf16*)(F.ws + WS_VT) + (size_t)unit * 32768;
#pragma unroll
      for (int i = 0; i < 8; ++i) { const int idx = i * 512 + F.tid, e = idx >> 4, chk = idx & 15; *(LAS u32x4*)(VT + e * VT_P + 8 * chk) = *(const u32x4*)(VTg + e * 128 + 8 * chk); } }
    bf16x8 qf[8];
#pragma unroll
    for (int ks = 0; ks < 8; ++ks) qf[ks] = __builtin_bit_cast(bf16x8, *(const u32x4*)(HB + (r0 + 16 * w + cl) * NB + h * 256 + 32 * ks + dq * 8));
    __syncthreads();
    pg8::f32x4 s[8];
#pragma unroll
    for (int mt = 0; mt < 8; ++mt) { s[mt] = (pg8::f32x4){0.f, 0.f, 0.f, 0.f};
        if (mt <= w) {
#pragma unroll
            for (int ks = 0; ks < 8; ++ks) { const bf16x8 Bf = *(const LAS bf16x8*)(KS + (16 * mt + cl) * KS_P + 32 * ks + dq * 8);
                s[mt] = __builtin_amdgcn_mfma_f32_16x16x32_bf16(qf[ks], Bf, s[mt], 0, 0, 0); } } }
    __syncthreads();
    LAS bf16* PW = (LAS bf16*)(F.lds) + w * 16 * PW_P;
#pragma unroll
    for (int mt = 0; mt < 8; ++mt)
#pragma unroll
        for (int r = 0; r < 4; ++r) { const int cc = 16 * w + dq * 4 + r, mm = 16 * mt + cl; const float dm = (mm <= cc) ? exp2f((float)(cc - mm) * lg) : 0.f;
            PW[(dq * 4 + r) * PW_P + mm] = (bf16)f2bf(s[mt][r] * dm); }
    LDS_WAIT(); asm volatile("" ::: "memory");
    pg8::f32x4 o[16];
#pragma unroll
    for (int et = 0; et < 16; ++et) o[et] = (pg8::f32x4){0.f, 0.f, 0.f, 0.f};
#pragma unroll
    for (int kc = 0; kc < 4; ++kc) if (kc <= (w >> 1)) { const bf16x8 Af = *(const LAS bf16x8*)(PW + cl * PW_P + 32 * kc + dq * 8);
#pragma unroll
        for (int et = 0; et < 16; ++et) { const bf16x8 Bf = *(const LAS bf16x8*)(VT + (16 * et + cl) * VT_P + 32 * kc + dq * 8);
            o[et] = __builtin_amdgcn_mfma_f32_16x16x32_bf16(Af, Bf, o[et], 0, 0, 0); } }
    const float* gnw = a.in[13] + h * 256;
#pragma unroll
    for (int r = 0; r < 4; ++r) { const size_t row = r0 + 16 * w + dq * 4 + r; bf16* mp = MIX + row * D + DR + h * 256 + cl; const bf16* gp = HB + row * NB + 3072 + h * 256 + cl;
        float sum = 0.f;
#pragma unroll
        for (int et = 0; et < 16; ++et) { o[et][r] += bf1(mp[16 * et]); sum += o[et][r]; }
        const float mean = row16_sum(sum) * (1.f / 256.f); float q = 0.f;
#pragma unroll
        for (int et = 0; et < 16; ++et) { const float d = o[et][r] - mean; q += d * d; }
        const float rstd = 1.f / sqrtf(row16_sum(q) * (1.f / 256.f) + RET_GN_EPS);
#pragma unroll
        for (int et = 0; et < 16; ++et) { const float g = bf1(gp[16 * et]); const float y = (o[et][r] - mean) * rstd * gnw[16 * et + cl] * (g * sigmoidf_(g)); mp[16 * et] = (bf16)f2bf(y); } }
    __syncthreads();
}
__device__ __forceinline__ void rwkv_finalize(Frame& F, const Args& a) {
    const Prep P = prep_ptrs(F); bf16* MIX = (bf16*)(F.ws + WS_MIX); const f16b* G = (const f16b*)(F.ws + WS_G);
    const int c0 = 16 * F.lane, hd = F.lane >> 2;
    float gw_[16], gb_[16];
#pragma unroll
    for (int j = 0; j < 4; ++j) { const f32x4 x = *(const f32x4*)(a.in[11] + c0 + 4 * j), y = *(const f32x4*)(a.in[12] + c0 + 4 * j);
        gw_[4 * j] = x.x; gw_[4 * j + 1] = x.y; gw_[4 * j + 2] = x.z; gw_[4 * j + 3] = x.w; gb_[4 * j] = y.x; gb_[4 * j + 1] = y.y; gb_[4 * j + 2] = y.z; gb_[4 * j + 3] = y.w; }
    for (int m = F.gw; m < M; m += F.NGW) {
        u32x4 yv[2], vv[2], gv[2];
        yv[0] = *(const u32x4*)(MIX + (size_t)m * D + c0); yv[1] = *(const u32x4*)(MIX + (size_t)m * D + c0 + 8);
        vv[0] = *(const u32x4*)(P.v + (size_t)m * DR + c0); vv[1] = *(const u32x4*)(P.v + (size_t)m * DR + c0 + 8);
        gv[0] = *(const u32x4*)(G + (size_t)m * DR + c0); gv[1] = *(const u32x4*)(G + (size_t)m * DR + c0 + 8);
        const float bon = P.bon[(size_t)m * 16 + hd];
        float y[16]; float s = 0.f;
#pragma unroll
        for (int j = 0; j < 8; ++j) { y[2 * j] = bf_lo(yv[j >> 2][j & 3]); y[2 * j + 1] = bf_hi(yv[j >> 2][j & 3]); s += y[2 * j] + y[2 * j + 1]; }
        s += __shfl_xor(s, 1); s += __shfl_xor(s, 2); const float mean = s * (1.f / 64.f); float q = 0.f;
#pragma unroll
        for (int j = 0; j < 16; ++j) { y[j] -= mean; q += y[j] * y[j]; }
        q += __shfl_xor(q, 1); q += __shfl_xor(q, 2); const float rstd = 1.f / sqrtf(q * (1.f / 64.f) + RWKV_GN_EPS);
        u32x4 ov[2];
#pragma unroll
        for (int j = 0; j < 8; ++j) { const unsigned vw = vv[j >> 2][j & 3], gw2 = gv[j >> 2][j & 3];
            const float o0 = (y[2 * j] * rstd * gw_[2 * j] + gb_[2 * j] + bon * h_lo(vw)) * h_lo(gw2);
            const float o1 = (y[2 * j + 1] * rstd * gw_[2 * j + 1] + gb_[2 * j + 1] + bon * h_hi(vw)) * h_hi(gw2);
            ov[j >> 2][j & 3] = pk2(o0, o1); }
        *(u32x4*)(MIX + (size_t)m * D + c0) = ov[0]; *(u32x4*)(MIX + (size_t)m * D + c0 + 8) = ov[1];
    }
}

constexpr int N_PHASES = 12;
__global__ void __launch_bounds__(NWAVES * 64, 2) fwd_kernel(Args args) {
    extern __shared__ __attribute__((aligned(16))) unsigned char lds_raw[];
    Frame F;
    F.lds = (LAS unsigned char*)lds_raw; F.ws = args.ws; F.out = args.out;
    F.tid = threadIdx.x; F.lane = F.tid & 63; F.wave = __builtin_amdgcn_readfirstlane(F.tid >> 6);
    F.G = gridDim.x; F.gw = blockIdx.x * NWAVES + F.wave; F.NGW = F.G * NWAVES;
    const int lo = args.ph_lo, hi = args.ph_hi;
#define IN(k) (lo <= (k) && (k) < hi)
    unsigned nbar = 0u; unsigned* gctr = (unsigned*)(args.ws + WS_CTL) + 128;
    volatile LAS unsigned* xst = (volatile LAS unsigned*)(F.lds + LDS_BYTES - 64);
    if (F.tid < 16) xst[F.tid] = 0u;
    __syncthreads();
    XcdBarrier xbar = xcd_barrier_post((unsigned*)(args.ws + WS_CTL) + 2048, xst);
#define SEAM(k) do { if (IN(k) && IN((k) + 1)) { if (args.coop == 1) { xcd_barrier(xbar); } else if (args.coop == 3) { nbar += (unsigned)F.G; sub_barrier(gctr, nbar); } else if (args.coop == 2) cg::this_grid().sync(); } } while (0)
    typedef pg8::bf16_t b16;
    if (IN(0)) { p0_prologue(F, args); } SEAM(0);
    if (IN(1)) {
        pg8::Gemm g{(const b16*)(F.ws + WS_XB), (const b16*)(F.ws + WS_WIN), M, N1A, D}; pg8::StaticOrder S; S.init(M, N1A, F.G, (int)blockIdx.x);
        pg8::EpiH16<0> E{(b16*)(F.ws + WS_HA), (b16*)(F.ws + WS_HB), (b16*)(F.ws + WS_HB), NA, NB, NB, NA, 1 << 30};
        pg8::gemm_phase<pg8::EpiH16<0>, pg8::StaticOrder, true, true>(F.lds, g, S, E);
    } SEAM(1);
    if (IN(2)) { p2a_prep(F, args); } SEAM(2);
    if (IN(3)) {
        pg8::Gemm g{(const b16*)((unsigned char*)F.out + OUT_AP), (const b16*)(F.ws + WS_WL), M, 3072, args.klora}; pg8::StaticOrder S; S.init(M, 3072, F.G, (int)blockIdx.x);
        pg8::EpiH16<2> E{(b16*)(F.ws + WS_LRW), (b16*)(F.ws + WS_LRA), (b16*)(F.ws + WS_G), DR, DR, DR, 1024, 2048};
        pg8::gemm_phase<pg8::EpiH16<2>, pg8::StaticOrder, true, true>(F.lds, g, S, E);
    } SEAM(3);
    if (IN(4)) { p2c_rwkv_prep(F, args); } SEAM(4);
    if (IN(5)) {
        if (blockIdx.x < 128) { rwkv_scan_unit(F, (int)blockIdx.x); }
        else {
            const int bb = (int)blockIdx.x - 128; unsigned* ctr = (unsigned*)(F.ws + WS_CTL) + 64;
            {
                pg8::Gemm g{(const b16*)(F.ws + WS_XB), (const b16*)(F.ws + WS_WIN) + (size_t)N1A * D, M, 6400 - N1A, D}; pg8::StaticOrder S; S.init(M, 6400 - N1A, 128, bb);
                pg8::EpiH16<0> E{(b16*)(F.ws + WS_HB) + (N1A - NA), (b16*)(F.ws + WS_HB), (b16*)(F.ws + WS_HB), NB, NB, NB, 1 << 30, 1 << 30};
                pg8::gemm_phase<pg8::EpiH16<0>, pg8::StaticOrder, true, true>(F.lds, g, S, E);
            }
            sub_barrier(ctr, 128u);
            ret_rotary(F, bb * NWAVES + F.wave, 128 * NWAVES);
            sub_barrier(ctr, 256u);
            for (int u = bb; u < 1024; u += 128) ret_transpose_unit(F, u);
            sub_barrier(ctr, 384u);
            if (bb < 64) ret_scan_unit(F, bb);
            else {
                p0_late_weights(F, args, (bb - 64) * NWAVES + F.wave, 64 * NWAVES);
                __syncthreads();
                pg8::Gemm g{(const b16*)(F.ws + WS_XB), (const b16*)(F.ws + WS_WIN) + (size_t)6400 * D, M, 1024, D}; pg8::StaticOrder S; S.init(M, 1024, 64, bb - 64);
                pg8::EpiH16<0> E{(b16*)(F.ws + WS_HB) + 3072, (b16*)(F.ws + WS_HB), (b16*)(F.ws + WS_HB), NB, NB, NB, 1 << 30, 1 << 30};
                pg8::gemm_phase<pg8::EpiH16<0>, pg8::StaticOrder, true, true>(F.lds, g, S, E);
            }
            sub_barrier(ctr, 512u);
        }
    }
    if (IN(5)) { if (blockIdx.x >= 128) { for (int u = (int)blockIdx.x - 128; u < 1024; u += 128) ret_intra_unit(F, args, u); } } SEAM(5);
    if (IN(6)) { rwkv_finalize(F, args); } SEAM(6);
    if (IN(7)) {
        pg8::Gemm g{(const b16*)(F.ws + WS_MIX), (const b16*)(F.ws + WS_WO), M, D, D}; pg8::StaticOrder S; S.init(M, D, F.G, (int)blockIdx.x);
        pg8::EpiH16<0> E{(b16*)(F.ws + WS_HB), (b16*)(F.ws + WS_HB), (b16*)(F.ws + WS_HB), D, D, D, 1 << 30, 1 << 30};
        pg8::gemm_phase<pg8::EpiH16<0>, pg8::StaticOrder, true, true>(F.lds, g, S, E);
    } SEAM(7);
    if (IN(8)) { ln_pass<false>(F, args.in[0], (const bf16*)(F.ws + WS_HB), nullptr, (bf16*)(F.ws + WS_X1B), args.in[15], args.in[16]); } SEAM(8);
    if (IN(9)) {
        pg8::Gemm g{(const b16*)(F.ws + WS_X1B), (const b16*)(F.ws + WS_WUP), M, DFF, D}; pg8::StaticOrder S; S.init(M, DFF, F.G, (int)blockIdx.x);
        pg8::EpiH16<1> E{(b16*)(F.ws + WS_U), (b16*)(F.ws + WS_U), (b16*)(F.ws + WS_U), DFF, DFF, DFF, 1 << 30, 1 << 30};
        pg8::gemm_phase<pg8::EpiH16<1>, pg8::StaticOrder, true, true>(F.lds, g, S, E);
    } SEAM(9);
    if (IN(10)) {
        pg8::Gemm g{(const b16*)(F.ws + WS_U), (const b16*)(F.ws + WS_WDN), M, D, DFF}; pg8::StaticOrder S; S.init(M, D, F.G, (int)blockIdx.x);
        pg8::EpiH16<0> E{(b16*)(F.ws + WS_KT), (b16*)(F.ws + WS_KT), (b16*)(F.ws + WS_KT), D, D, D, 1 << 30, 1 << 30};
        pg8::gemm_phase<pg8::EpiH16<0>, pg8::StaticOrder, true, true>(F.lds, g, S, E);
    } SEAM(10);
    if (IN(11)) { ln_pass<true>(F, (const bf16*)(F.ws + WS_X1B), (const bf16*)(F.ws + WS_KT), F.out, nullptr, args.in[19], args.in[20]); }
#undef IN
#undef SEAM
}

extern "C" void kernel_launch(void* const* d_in, const int* in_sizes, int n_in, void* d_out, int out_size, void* d_ws, size_t ws_size, hipStream_t stream) {
    static int grid = 0;
    if (grid == 0) {
        if (n_in != 21 || in_sizes[0] != M * D || out_size != M * D || ws_size < WS_END) { fprintf(stderr, "kernel_launch: unexpected shapes: n_in %d in0 %d out %d ws %zu\n", n_in, n_in > 0 ? in_sizes[0] : -1, out_size, ws_size); grid = -1; return; }
        int dev = 0, cus = 0;
        if (hipGetDevice(&dev) != hipSuccess || hipDeviceGetAttribute(&cus, hipDeviceAttributeMultiprocessorCount, dev) != hipSuccess) { grid = -1; return; }
        if (hipFuncSetAttribute((const void*)fwd_kernel, hipFuncAttributeMaxDynamicSharedMemorySize, LDS_BYTES) != hipSuccess) { fprintf(stderr, "kernel_launch: hipFuncSetAttribute failed\n"); grid = -1; return; }
        (void)hipGetLastError();
        if (cus < 256) { fprintf(stderr, "kernel_launch: this kernel splits phase 5 over exactly 256 co-resident workgroups; device has %d CUs\n", cus); grid = -1; return; }
        grid = 256;
    }
    if (grid < 0) return;
    (void)hipMemsetAsync(d_ws, 0, 32768, stream);
    Args a{};
    for (int i = 0; i < 21; ++i) a.in[i] = (const float*)d_in[i];
    a.out = (float*)d_out; a.ws = (unsigned char*)d_ws; a.klora = NLORA;
    a.ph_lo = 0; a.ph_hi = N_PHASES; a.coop = 1;
    void* kargs[] = {&a};
    hipError_t e = hipLaunchCooperativeKernel((const void*)fwd_kernel, dim3(grid), dim3(NWAVES * 64), kargs, LDS_BYTES, stream);
    if (e != hipSuccess) fprintf(stderr, "kernel_launch: cooperative launch failed: %s (grid %d)\n", hipGetErrorString(e), grid);
}
```

```cpp
#include <hip/hip_runtime.h>
#include <hip/hip_cooperative_groups.h>
#include <cstdio>
#include <cstdint>
namespace cg = cooperative_groups;
namespace pg8 {
#define PG8_LAS __attribute__((address_space(3)))
typedef unsigned short bf16_t;
typedef short bf16x8 __attribute__((ext_vector_type(8)));
typedef float f32x4 __attribute__((ext_vector_type(4)));
typedef unsigned u32x4 __attribute__((ext_vector_type(4)));
constexpr int BM = 256, BK = 64, HALF = 128, HTB = HALF * BK * 2  , STAGE_BYTES = 8 * HTB, NXCD = 8, WGM = 8;

__host__ __device__ __forceinline__ int lds_byte(int r, int c) { const int st = (r >> 4) * 2 + (c >> 5), rr = r & 15, cc = c & 31, ob = rr * 64 + cc * 2; return st * 1024 + (ob ^ (((ob >> 9) & 1) << 5)); }
__host__ __device__ __forceinline__ void stage_rc(int b, int& R, int& C) { const int st = b / 1024, sb = b % 1024, swz = sb ^ (((sb >> 9) & 1) << 5); R = (st >> 1) * 16 + swz / 64; C = (st & 1) * 32 + (swz % 64) / 2; }
__host__ __device__ __forceinline__ int perm32(int rho) { const int n = rho >> 4, i = rho & 15; return 8 * (i >> 2) + 4 * n + (i & 3); }

struct Unit { int pm, pn; };
struct Gemm { const bf16_t* A; const bf16_t* Bt; int M, N, K; };

struct StaticOrder {
    int nM, nN, nwg, G, c;
    __host__ __device__ void init(int M, int N, int G_, int c_) { nM = M / BM; nN = N / BM; nwg = nM * nN; G = G_; c = c_; }
    __host__ __device__ bool next(int i, Unit& u) const {
        const long L = (long)i * G + c; if (L >= nwg) return false;
        int wgid = (int)L; { const int q = nwg / NXCD, r = nwg % NXCD, xcd = wgid % NXCD, off = wgid / NXCD; wgid = (xcd < r ? xcd * (q + 1) : r * (q + 1) + (xcd - r) * q) + off; }
        const int nig = WGM * nN, gid = wgid / nig, fm = gid * WGM, gsz = (nM - fm) < WGM ? (nM - fm) : WGM;
        u.pm = fm + ((wgid % nig) % gsz); u.pn = (wgid % nig) / gsz; return true;
    }
    __device__ __forceinline__ void a_ready(const Unit&) const {}
    __device__ __forceinline__ void done(const Unit&) const {}
};

__device__ __forceinline__ unsigned cvt_pk_bf16(float lo, float hi) { unsigned r; asm volatile("v_cvt_pk_bf16_f32 %0, %1, %2" : "=v"(r) : "v"(lo), "v"(hi)); return r; }
typedef _Float16 f16x2_t __attribute__((ext_vector_type(2)));
__device__ __forceinline__ unsigned cvt_pk_f16(float lo, float hi) { f16x2_t v; v.x = (_Float16)lo; v.y = (_Float16)hi; return __builtin_bit_cast(unsigned, v); }
template <int MODE> struct EpiH16 {
    static constexpr bool PERM = true, AFTER_DRAIN = false;
    bf16_t* O0; bf16_t* O1; bf16_t* O2; int ld0, ld1, ld2, split0, split1;
    __device__ __forceinline__ void operator()(const f32x4 (&acc)[2][2][4][2], const Unit& u, int wr, int wc, int fr, int fq) const {
        const int row0 = u.pm * BM + wr * 64 + fr; int colt = u.pn * BM; bf16_t* base = O0; int ldc = ld0;
        if (colt >= split1) { base = O2; ldc = ld2; colt -= split1; } else if (colt >= split0) { base = O1; ldc = ld1; colt -= split0; }
        const int col0 = colt + wc * 32 + 8 * fq;
#pragma unroll
        for (int ai = 0; ai < 2; ++ai)
#pragma unroll
            for (int m = 0; m < 4; ++m) { bf16_t* rowp = base + (size_t)(row0 + ai * HALF + m * 16) * ldc + col0;
#pragma unroll
                for (int bj = 0; bj < 2; ++bj) { f32x4 v0 = acc[ai][bj][m][0], v1 = acc[ai][bj][m][1];
                    if (MODE == 1) {
#pragma unroll
                        for (int e = 0; e < 4; ++e) { float a = fmaxf(v0[e], 0.f), b = fmaxf(v1[e], 0.f); v0[e] = a * a; v1[e] = b * b; } }
                    u32x4 w;
                    if (MODE == 2) { w.x = cvt_pk_f16(v0[0], v0[1]); w.y = cvt_pk_f16(v0[2], v0[3]); w.z = cvt_pk_f16(v1[0], v1[1]); w.w = cvt_pk_f16(v1[2], v1[3]); }
                    else { w.x = cvt_pk_bf16(v0[0], v0[1]); w.y = cvt_pk_bf16(v0[2], v0[3]); w.z = cvt_pk_bf16(v1[0], v1[1]); w.w = cvt_pk_bf16(v1[2], v1[3]); }
                    *(u32x4*)(rowp + bj * HALF) = w; } }
    }
};
struct EpiResid {
    static constexpr bool PERM = false, AFTER_DRAIN = false;
    const float* base; float* out; int ldc; float alpha;
    __device__ __forceinline__ void operator()(const f32x4 (&acc)[2][2][4][2], const Unit& u, int wr, int wc, int fr, int fq) const {
        const int row0 = u.pm * BM + wr * 64 + fr, col0 = u.pn * BM + wc * 32 + 4 * fq;
#pragma unroll
        for (int ai = 0; ai < 2; ++ai)
#pragma unroll
            for (int m = 0; m < 4; ++m) { const size_t off = (size_t)(row0 + ai * HALF + m * 16) * ldc + col0;
#pragma unroll
                for (int bj = 0; bj < 2; ++bj)
#pragma unroll
                    for (int n = 0; n < 2; ++n) { const size_t p = off + bj * HALF + n * 16; const f32x4 b = *(const f32x4*)(base + p); *(f32x4*)(out + p) = b * alpha + acc[ai][bj][m][n]; } }
    }
};
template <class Epi, class Sched, bool ALIGN_EPI = false, bool SP2 = false>
__device__ __forceinline__ void gemm_phase(PG8_LAS unsigned char* lds, const Gemm g, const Sched& S, const Epi& E) {
    const int tid = threadIdx.x, wid = __builtin_amdgcn_readfirstlane(tid >> 6), lane = tid & 63, wr = wid >> 2, wc = wid & 3, fr = lane & 15, fq = lane >> 4;
    const int K = g.K, nt = K / BK;
    unsigned voffA[2], voffB[2];
#pragma unroll
    for (int i = 0; i < 2; ++i) { int R, C; stage_rc(tid * 16 + i * 8192, R, C); const int Rb = Epi::PERM ? ((R & ~31) + perm32(R & 31)) : R;
        voffA[i] = (unsigned)(R * K + C) * 2u; voffB[i] = (unsigned)(Rb * K + C) * 2u; }
    const size_t kstep = (size_t)(BK * 2);
    const size_t hstep = (size_t)HALF * K * 2;
    const size_t tstep = 2 * hstep;
    const unsigned ldsw = (unsigned)wid * 1024u;
    const int aoff = lds_byte(wr * 64 + fr, fq * 8), boff = lds_byte(wc * 32 + fr, fq * 8);
#define PG8_SA(b, h) (((b) * 2 + (h)) * HTB)
#define PG8_SB(b, h) ((4 + (b) * 2 + (h)) * HTB)
#define PG8_STAGE(bufoff, gbase, voff) do { _Pragma("unroll") for (int _i = 0; _i < 2; ++_i) \
        __builtin_amdgcn_global_load_lds((const unsigned*)((const char*)(gbase) + (voff)[_i]), (PG8_LAS unsigned*)(lds + (bufoff) + ldsw + _i * 8192), 16, 0, 0); } while (0)
#define PG8_LDA(dst, b, h) do { _Pragma("unroll") for (int m = 0; m < 4; ++m) _Pragma("unroll") for (int k = 0; k < 2; ++k) dst[m][k] = *(const PG8_LAS bf16x8*)(lds + PG8_SA(b, h) + aoff + m * 2048 + k * 1024); } while (0)
#define PG8_LDB(dst, b, h) do { _Pragma("unroll") for (int n = 0; n < 2; ++n) _Pragma("unroll") for (int k = 0; k < 2; ++k) dst[n][k] = *(const PG8_LAS bf16x8*)(lds + PG8_SB(b, h) + boff + n * 2048 + k * 1024); } while (0)
#define PG8_MMA(ai, bj, At, Bt) do { __builtin_amdgcn_s_setprio(1); _Pragma("unroll") for (int m = 0; m < 4; ++m) _Pragma("unroll") for (int n = 0; n < 2; ++n) _Pragma("unroll") for (int k = 0; k < 2; ++k) \
        acc[ai][bj][m][n] = __builtin_amdgcn_mfma_f32_16x16x32_bf16(Bt[n][k], At[m][k], acc[ai][bj][m][n], 0, 0, 0); __builtin_amdgcn_s_setprio(0); } while (0)
#define PG8_WAIT_V(n) asm volatile("s_waitcnt vmcnt(" #n ")" ::: "memory")
#define PG8_WAIT_L(n) asm volatile("s_waitcnt lgkmcnt(" #n ")" ::: "memory")
#define PG8_BAR __builtin_amdgcn_s_barrier()
#define PG8_SCHED __builtin_amdgcn_sched_barrier(0)
    Unit cur, nxt; int ui = 0;
    if (!S.next(0, cur)) return;
    f32x4 acc[2][2][4][2];
#pragma unroll
    for (int a = 0; a < 2; ++a)
#pragma unroll
        for (int b = 0; b < 2; ++b)
#pragma unroll
            for (int m = 0; m < 4; ++m)
#pragma unroll
                for (int n = 0; n < 2; ++n) acc[a][b][m][n] = (f32x4){0.f, 0.f, 0.f, 0.f};
    bf16x8 At[4][2], B0[2][2], B1[2][2];
    const char* cA = (const char*)g.A + (size_t)cur.pm * tstep; const char* cB = (const char*)g.Bt + (size_t)cur.pn * tstep;
    S.a_ready(cur);
    if constexpr (SP2) {
        PG8_STAGE(PG8_SB(0, 0), cB, voffB); PG8_STAGE(PG8_SB(0, 1), cB + hstep, voffB); PG8_STAGE(PG8_SA(0, 0), cA, voffA); PG8_STAGE(PG8_SA(0, 1), cA + hstep, voffA);
        if (wr == 1) PG8_BAR;
        PG8_WAIT_V(2); PG8_BAR;
        PG8_STAGE(PG8_SB(1, 0), cB + kstep, voffB); PG8_STAGE(PG8_SA(1, 0), cA + kstep, voffA); PG8_STAGE(PG8_SB(1, 1), cB + hstep + kstep, voffB);
        PG8_WAIT_V(6); PG8_BAR;
    } else {
        PG8_STAGE(PG8_SB(0, 0), cB, voffB); PG8_STAGE(PG8_SA(0, 0), cA, voffA); PG8_STAGE(PG8_SB(0, 1), cB + hstep, voffB); PG8_STAGE(PG8_SA(0, 1), cA + hstep, voffA);
        if (wr == 1) PG8_BAR;
        PG8_WAIT_V(4); PG8_BAR;
        PG8_STAGE(PG8_SB(1, 0), cB + kstep, voffB); PG8_STAGE(PG8_SA(1, 0), cA + kstep, voffA); PG8_STAGE(PG8_SB(1, 1), cB + hstep + kstep, voffB);
        PG8_WAIT_V(6); PG8_BAR;
    }
    for (;;) {
        const bool has_next = S.next(ui + 1, nxt);
        const char* nA = has_next ? (const char*)g.A + (size_t)nxt.pm * tstep : cA; const char* nB = has_next ? (const char*)g.Bt + (size_t)nxt.pn * tstep : cB;
        for (int t = 0; t < nt; t += 2) {
            const bool last = (t == nt - 2);
            const char* a1 = cA + (size_t)(t + 1) * kstep;
            const char* a2 = last ? nA : cA + (size_t)(t + 2) * kstep; const char* b2 = last ? nB : cB + (size_t)(t + 2) * kstep;
            const char* a3 = a2 + kstep; const char* b3 = b2 + kstep;
            if (last && has_next) S.a_ready(nxt);
            if constexpr (SP2) {
            PG8_LDB(B0, 0, 0); PG8_LDB(B1, 0, 1); PG8_SCHED; PG8_LDA(At, 0, 0); PG8_STAGE(PG8_SA(1, 1), a1 + hstep, voffA);
            PG8_WAIT_V(8); PG8_WAIT_L(0); PG8_BAR; PG8_MMA(0, 0, At, B0); PG8_MMA(0, 1, At, B1); PG8_BAR; PG8_SCHED;
            PG8_LDA(At, 0, 1); PG8_STAGE(PG8_SB(0, 0), b2, voffB); PG8_STAGE(PG8_SB(0, 1), b2 + hstep, voffB); PG8_STAGE(PG8_SA(0, 0), a2, voffA);
            PG8_WAIT_V(8); PG8_WAIT_L(0); PG8_BAR; PG8_MMA(1, 0, At, B0); PG8_MMA(1, 1, At, B1); PG8_BAR; PG8_SCHED;
            PG8_LDB(B0, 1, 0); PG8_LDB(B1, 1, 1); PG8_SCHED; PG8_LDA(At, 1, 0); PG8_STAGE(PG8_SA(0, 1), a2 + hstep, voffA);
            PG8_WAIT_V(8); PG8_WAIT_L(0); PG8_BAR; PG8_MMA(0, 0, At, B0); PG8_MMA(0, 1, At, B1); PG8_BAR; PG8_SCHED;
            PG8_LDA(At, 1, 1); PG8_STAGE(PG8_SB(1, 0), b3, voffB); PG8_STAGE(PG8_SB(1, 1), b3 + hstep, voffB); PG8_STAGE(PG8_SA(1, 0), a3, voffA);
            PG8_WAIT_V(8); PG8_WAIT_L(0); PG8_BAR; PG8_MMA(1, 0, At, B0); PG8_MMA(1, 1, At, B1); PG8_BAR; PG8_SCHED;
            } else {
            PG8_LDB(B0, 0, 0); PG8_SCHED; PG8_LDA(At, 0, 0); PG8_STAGE(PG8_SA(1, 1), a1 + hstep, voffA);
            PG8_WAIT_L(8); PG8_BAR; PG8_WAIT_L(0); PG8_MMA(0, 0, At, B0); PG8_BAR; PG8_SCHED;
            PG8_LDB(B1, 0, 1); PG8_STAGE(PG8_SB(0, 0), b2, voffB);
            PG8_BAR; PG8_WAIT_L(0); PG8_MMA(0, 1, At, B1); PG8_BAR;
            PG8_LDA(At, 0, 1); PG8_STAGE(PG8_SA(0, 0), a2, voffA);
            PG8_BAR; PG8_WAIT_L(0); PG8_MMA(1, 0, At, B0); PG8_BAR; PG8_SCHED;
            PG8_STAGE(PG8_SB(0, 1), b2 + hstep, voffB);
            PG8_WAIT_V(6); PG8_BAR; PG8_MMA(1, 1, At, B1); PG8_BAR;
            PG8_LDB(B0, 1, 0); PG8_SCHED; PG8_LDA(At, 1, 0); PG8_STAGE(PG8_SA(0, 1), a2 + hstep, voffA);
            PG8_WAIT_L(8); PG8_BAR; PG8_WAIT_L(0); PG8_MMA(0, 0, At, B0); PG8_BAR; PG8_SCHED;
            PG8_LDB(B1, 1, 1); PG8_STAGE(PG8_SB(1, 0), b3, voffB);
            PG8_BAR; PG8_WAIT_L(0); PG8_MMA(0, 1, At, B1); PG8_BAR;
            PG8_LDA(At, 1, 1); PG8_STAGE(PG8_SA(1, 0), a3, voffA);
            PG8_BAR; PG8_WAIT_L(0); PG8_MMA(1, 0, At, B0); PG8_BAR; PG8_SCHED;
            PG8_STAGE(PG8_SB(1, 1), b3 + hstep, voffB);
            PG8_WAIT_V(6); PG8_BAR; PG8_MMA(1, 1, At, B1); PG8_BAR;
            }
        }
        if constexpr (ALIGN_EPI) { if (wr == 0) PG8_BAR; }
        if constexpr (!Epi::AFTER_DRAIN) { E(acc, cur, wr, wc, fr, fq); S.done(cur); }
        if (!has_next) break;
#pragma unroll
        for (int a = 0; a < 2; ++a)
#pragma unroll
            for (int b = 0; b < 2; ++b)
#pragma unroll
                for (int m = 0; m < 4; ++m)
#pragma unroll
                    for (int n = 0; n < 2; ++n) acc[a][b][m][n] = (f32x4){0.f, 0.f, 0.f, 0.f};
        cur = nxt; cA = nA; cB = nB; ++ui;
        if constexpr (ALIGN_EPI) { if (wr == 1) PG8_BAR; }
    }
    PG8_WAIT_V(0);
    if constexpr (!ALIGN_EPI) { if (wr == 0) PG8_BAR; }
    PG8_BAR;
    if constexpr (Epi::AFTER_DRAIN) { E.fused(acc, cur, wr, wc, fr, fq, lds, wid, lane); S.done(cur); }
#undef PG8_SA
#undef PG8_SB
#undef PG8_STAGE
#undef PG8_LDA
#undef PG8_LDB
#undef PG8_MMA
#undef PG8_WAIT_V
#undef PG8_WAIT_L
#undef PG8_BAR
#undef PG8_SCHED
}
}
constexpr int NWAVES = 8;
constexpr int BATCH = 2, T = 16384, M = BATCH * T, D = 2048, NIN = 7424, DFF = 8192;
constexpr int NA = 3328, NB = 4096;
constexpr int DR = 1024;
constexpr int NLORA = 256;
constexpr float LN_EPS = 1e-5f, RWKV_GN_EPS = 64e-5f, RET_GN_EPS = 1e-6f;
constexpr float ALPHA = 1.189207115002721f;
constexpr size_t MiB = 1u << 20;
constexpr size_t WS_CTL = 0, WS_WL = 1 * MiB, WS_BON = 3 * MiB, WS_WIN = 8 * MiB, WS_WO = 38 * MiB, WS_WUP = 46 * MiB, WS_WDN = 78 * MiB;
constexpr size_t WS_XB = 112 * MiB;
constexpr size_t WS_HA = 240 * MiB, WS_MIX = 240 * MiB, WS_HB = 448 * MiB;
constexpr size_t WS_G = 704 * MiB, WS_P5 = 768 * MiB, WS_P6 = 832 * MiB, WS_LRW = 896 * MiB, WS_LRA = 960 * MiB, WS_END = 1024 * MiB;
constexpr size_t WS_U = 240 * MiB, WS_X1B = 768 * MiB;
constexpr size_t OUT_AP = 0;
static_assert(WS_HA + (size_t)M * NA * 2 <= WS_HB && WS_HB + (size_t)M * NB * 2 <= WS_G && WS_U + (size_t)M * DFF * 2 <= WS_X1B, "ws map");
constexpr int N1A = NA + 256;
constexpr int LDS_BYTES = 163840;
#define LAS __attribute__((address_space(3)))
typedef unsigned short bf16;
typedef unsigned short f16b;
typedef float f32x4 __attribute__((ext_vector_type(4)));
typedef float f32x2 __attribute__((ext_vector_type(2)));
typedef unsigned u32x4 __attribute__((ext_vector_type(4)));
typedef unsigned u32x2 __attribute__((ext_vector_type(2)));
typedef short bf16x8 __attribute__((ext_vector_type(8)));
typedef _Float16 h16x2 __attribute__((ext_vector_type(2)));
typedef _Float16 h16x8 __attribute__((ext_vector_type(8)));
#define LDS_WAIT() asm volatile("s_waitcnt lgkmcnt(0)" ::: "memory")

__device__ __forceinline__ unsigned f2bf(float f) { unsigned u = __builtin_bit_cast(unsigned, f); return (u + 0x7fffu + ((u >> 16) & 1u)) >> 16; }
__device__ __forceinline__ unsigned pk2(float lo, float hi) { return f2bf(lo) | (f2bf(hi) << 16); }
__device__ __forceinline__ float bf_lo(unsigned w) { return __builtin_bit_cast(float, w << 16); }
__device__ __forceinline__ float bf_hi(unsigned w) { return __builtin_bit_cast(float, w & 0xffff0000u); }
__device__ __forceinline__ float bf1(bf16 v) { return __builtin_bit_cast(float, (unsigned)v << 16); }
__device__ __forceinline__ unsigned pkh(float lo, float hi) { h16x2 v; v.x = (_Float16)lo; v.y = (_Float16)hi; return __builtin_bit_cast(unsigned, v); }
__device__ __forceinline__ float h_lo(unsigned w) { h16x2 v = __builtin_bit_cast(h16x2, w); return (float)v.x; }
__device__ __forceinline__ float h_hi(unsigned w) { h16x2 v = __builtin_bit_cast(h16x2, w); return (float)v.y; }
__device__ __forceinline__ float wave_sum(float v) {
#pragma unroll
    for (int o = 1; o < 64; o <<= 1) v += __shfl_xor(v, o);
    return v;
}
template <int CTRL> __device__ __forceinline__ float dpp_mov(float x) { return __builtin_bit_cast(float, __builtin_amdgcn_update_dpp(0, __builtin_bit_cast(int, x), CTRL, 0xF, 0xF, true)); }
__device__ __forceinline__ float row16_sum(float x) { x += dpp_mov<0x128>(x); x += dpp_mov<0x124>(x); x += dpp_mov<0x122>(x); x += dpp_mov<0x121>(x); return x; }
__device__ __forceinline__ float fma_s(float a, float b, float c) { float d; asm("v_fma_f32 %0, %1, %2, %3" : "=v"(d) : "v"(a), "v"(b), "v"(c)); return d; }
__device__ __forceinline__ float fnma_s(float a, float b, float c) { float d; asm("v_fma_f32 %0, -%1, %2, %3" : "=v"(d) : "v"(a), "v"(b), "v"(c)); return d; }
__device__ __forceinline__ float mul_s(float a, float b) { float d; asm("v_mul_f32 %0, %1, %2" : "=v"(d) : "v"(a), "v"(b)); return d; }
__device__ __forceinline__ float sigmoidf_(float x) { return 1.f / (1.f + __expf(-x)); }

struct Args { const float* in[21]; float* out; unsigned char* ws; int ph_lo, ph_hi, coop, klora, reps, pad; };
struct Frame {
    LAS unsigned char* lds; unsigned char* ws; float* out;
    int tid, lane, wave, G, gw, NGW;
};

__device__ __forceinline__ void p0_transpose_item(const float* W, int K, int N, bf16* WT, LAS float* scr, int item, int lane, bool remap) {
    const int nblk = N / 32, kb = item / nblk, nb = item % nblk, k0 = 64 * kb, n0 = 32 * nb;
    const int nd = !remap ? n0 : (n0 < NA ? n0 : (n0 >= 6400 ? n0 - 6400 + NA : n0 + 1024));
#pragma unroll 32
    for (int i = 0; i < 32; ++i) { const int kk = 2 * i + (lane >> 5); scr[kk * 33 + (lane & 31)] = W[(size_t)(k0 + kk) * N + n0 + (lane & 31)]; }
    LDS_WAIT(); asm volatile("" ::: "memory");
    const int c = lane & 7;
#pragma unroll
    for (int j = 0; j < 4; ++j) { const int n = (lane >> 3) + 8 * j; const LAS float* s = scr + (8 * c) * 33 + n;
        u32x4 o; o.x = pk2(s[0 * 33], s[1 * 33]); o.y = pk2(s[2 * 33], s[3 * 33]); o.z = pk2(s[4 * 33], s[5 * 33]); o.w = pk2(s[6 * 33], s[7 * 33]);
        *(u32x4*)(WT + (size_t)(nd + n) * K + k0 + 8 * c) = o; }
    LDS_WAIT(); asm volatile("" ::: "memory");
}
__device__ __forceinline__ void p0_late_weights(Frame& F, const Args& a, int w, int nw) {
    LAS float* scr = (LAS float*)(F.lds + F.wave * 16384);
    const float *w_o = a.in[14], *w_up = a.in[17], *w_dn = a.in[18];
    bf16 *WO = (bf16*)(F.ws + WS_WO), *WUP = (bf16*)(F.ws + WS_WUP), *WDN = (bf16*)(F.ws + WS_WDN);
    constexpr int I_O = (D / 64) * (D / 32), I_UP = (D / 64) * (DFF / 32), I_DN = (DFF / 64) * (D / 32);
    for (int it = w; it < I_O + I_UP + I_DN; it += nw) {
        int r = it;
        if (r < I_O) { p0_transpose_item(w_o, D, D, WO, scr, r, F.lane, false); continue; } r -= I_O;
        if (r < I_UP) { p0_transpose_item(w_up, D, DFF, WUP, scr, r, F.lane, false); continue; } r -= I_UP;
        p0_transpose_item(w_dn, DFF, D, WDN, scr, r, F.lane, false);
    }
}
__device__ __forceinline__ void p0_prologue(Frame& F, const Args& a) {
    LAS float* scr = (LAS float*)(F.lds + F.wave * 16384);
    { const float* w_in = a.in[1]; bf16* WIN = (bf16*)(F.ws + WS_WIN);
      constexpr int I_IN = (D / 64) * (NIN / 32);
      for (int it = F.gw; it < I_IN; it += F.NGW) p0_transpose_item(w_in, D, NIN, WIN, scr, it, F.lane, false); }
    const int gt = F.gw * 64 + F.lane, NGT = F.NGW * 64;
    { bf16* WL = (bf16*)(F.ws + WS_WL); const float *wl = a.in[4], *al = a.in[6], *gl = a.in[7];
      for (int idx = gt; idx < 3072 * NLORA; idx += NGT) { const int n = idx >> 8, k = idx & 255; float v = 0.f;
          if (n < 1024) { if (k < 64) v = wl[k * 1024 + n]; }
          else if (n < 2048) { if (k >= 64 && k < 128) v = al[(k - 64) * 1024 + (n - 1024)]; }
          else { if (k >= 128) v = gl[(k - 128) * 1024 + (n - 2048)]; }
          WL[idx] = (bf16)f2bf(v); } }
    { const float* x = a.in[0]; bf16* XB = (bf16*)(F.ws + WS_XB);
      for (size_t c = gt; c < (size_t)M * D / 8; c += (size_t)4 * NGT) { f32x4 v0[4], v1[4];
#pragma unroll
          for (int q = 0; q < 4; ++q) { const size_t cc = c + (size_t)q * NGT; v0[q] = __builtin_nontemporal_load((const f32x4*)(x + cc * 8)); v1[q] = __builtin_nontemporal_load((const f32x4*)(x + cc * 8 + 4)); }
#pragma unroll
          for (int q = 0; q < 4; ++q) { const size_t cc = c + (size_t)q * NGT; u32x4 o; o.x = pk2(v0[q].x, v0[q].y); o.y = pk2(v0[q].z, v0[q].w); o.z = pk2(v1[q].x, v1[q].y); o.w = pk2(v1[q].z, v1[q].w); *(u32x4*)(XB + cc * 8) = o; } } }
}

template <bool IN16> __device__ __forceinline__ void ln_pass(Frame& F, const void* in, const bf16* add, float* out, bf16* outb, const float* w, const float* b) {
    for (int m0 = 2 * F.gw; m0 < M; m0 += 2 * F.NGW) {
        f32x4 v[2][8]; u32x2 av[2][8], iv[2][8]; float s[2] = {0.f, 0.f};
#pragma unroll
        for (int r = 0; r < 2; ++r) { const u32x2* ar = (const u32x2*)(add + (size_t)(m0 + r) * D) + F.lane;
#pragma unroll
            for (int j = 0; j < 8; ++j) { av[r][j] = __builtin_nontemporal_load(ar + 64 * j);
                if (IN16) iv[r][j] = __builtin_nontemporal_load((const u32x2*)((const bf16*)in + (size_t)(m0 + r) * D) + F.lane + 64 * j);
                else v[r][j] = __builtin_nontemporal_load((const f32x4*)((const float*)in + (size_t)(m0 + r) * D) + F.lane + 64 * j); } }
#pragma unroll
        for (int r = 0; r < 2; ++r) {
#pragma unroll
            for (int j = 0; j < 8; ++j) { if (IN16) v[r][j] = (f32x4){bf_lo(iv[r][j].x), bf_hi(iv[r][j].x), bf_lo(iv[r][j].y), bf_hi(iv[r][j].y)};
                v[r][j] = v[r][j] * ALPHA + (f32x4){bf_lo(av[r][j].x), bf_hi(av[r][j].x), bf_lo(av[r][j].y), bf_hi(av[r][j].y)}; s[r] += (v[r][j].x + v[r][j].y) + (v[r][j].z + v[r][j].w); }
            const float mean = wave_sum(s[r]) * (1.f / D); float s2 = 0.f;
#pragma unroll
            for (int j = 0; j < 8; ++j) { v[r][j] = v[r][j] - mean; s2 += (v[r][j].x * v[r][j].x + v[r][j].y * v[r][j].y) + (v[r][j].z * v[r][j].z + v[r][j].w * v[r][j].w); }
            const float rstd = 1.f / sqrtf(wave_sum(s2) * (1.f / D) + LN_EPS);
#pragma unroll
            for (int j = 0; j < 8; ++j) { const f32x4 wv = ((const f32x4*)w)[64 * j + F.lane], bv = ((const f32x4*)b)[64 * j + F.lane];
                const f32x4 q = v[r][j] * rstd * wv + bv;
                if (out) __builtin_nontemporal_store(q, (f32x4*)(out + (size_t)(m0 + r) * D) + F.lane + 64 * j);
                if (outb) { u32x2 p; p.x = pk2(q.x, q.y); p.y = pk2(q.z, q.w); __builtin_nontemporal_store(p, (u32x2*)(outb + (size_t)(m0 + r) * D) + 64 * j + F.lane); } }
        }
    }
}

__device__ __forceinline__ void p2a_prep(Frame& F, const Args& a) {
    const bf16* HA = (const bf16*)(F.ws + WS_HA); bf16* AP = (bf16*)((unsigned char*)F.out + OUT_AP);
    const int j0 = 4 * F.lane; const f32x4 mu4 = *(const f32x4*)(a.in[2] + 3072 + j0);
#pragma unroll 2
    for (int m = F.gw; m < M; m += F.NGW) {
        const int t = m & (T - 1);
        const u32x2 cur = *(const u32x2*)(HA + (size_t)m * NA + 3072 + j0); u32x2 prv = (u32x2){0u, 0u};
        if (t > 0) prv = *(const u32x2*)(HA + (size_t)(m - 1) * NA + 3072 + j0);
        float c[4] = {bf_lo(cur.x), bf_hi(cur.x), bf_lo(cur.y), bf_hi(cur.y)}, p[4] = {bf_lo(prv.x), bf_hi(prv.x), bf_lo(prv.y), bf_hi(prv.y)};
        const float mu[4] = {mu4.x, mu4.y, mu4.z, mu4.w}; float f[4];
#pragma unroll
        for (int e = 0; e < 4; ++e) { float v = c[e] + (p[e] - c[e]) * mu[e];
            if (F.lane < 16) v = 1.f - 2.f / (1.f + __expf(2.f * v));
            else if (F.lane >= 32) v = sigmoidf_(v);
            f[e] = v; }
        u32x2 o; o.x = pk2(f[0], f[1]); o.y = pk2(f[2], f[3]); *(u32x2*)(AP + (size_t)m * NLORA + j0) = o;
    }
}
__device__ __forceinline__ void ret_rotary(Frame& F, int w, int nw) {
    bf16* HB = (bf16*)(F.ws + WS_HB);
    const float if0 = 1.0f / exp2f((float)F.lane * (13.287712379549449f / 127.0f)), if1 = 1.0f / exp2f((float)(64 + F.lane) * (13.287712379549449f / 127.0f));
    for (int m = w; m < M; m += nw) {
        const int t = m & (T - 1);
        const float th0 = (float)t * if0, th1 = (float)t * if1;
        const double r0 = (double)th0 * 0.15915494309189535, r1 = (double)th1 * 0.15915494309189535;
        const float f0 = (float)(r0 - __builtin_rint(r0)), f1 = (float)(r1 - __builtin_rint(r1));
        const float c0 = __builtin_amdgcn_cosf(f0), s0 = __builtin_amdgcn_sinf(f0), c1 = __builtin_amdgcn_cosf(f1), s1 = __builtin_amdgcn_sinf(f1);
        unsigned qv[8], kv[8];
#pragma unroll
        for (int it = 0; it < 8; ++it) { const int p = it * 64 + F.lane, hd = p >> 7, i = p & 127;
            qv[it] = *(const unsigned*)(HB + (size_t)m * NB + hd * 256 + 2 * i); kv[it] = *(const unsigned*)(HB + (size_t)m * NB + 1024 + hd * 256 + 2 * i); }
#pragma unroll
        for (int it = 0; it < 8; ++it) { const int p = it * 64 + F.lane, hd = p >> 7, i = p & 127; const float cs = (it & 1) ? c1 : c0, sn = (it & 1) ? s1 : s0;
            const float q1 = bf_lo(qv[it]), q2 = bf_hi(qv[it]), k1 = bf_lo(kv[it]), k2 = bf_hi(kv[it]);
            *(unsigned*)(HB + (size_t)m * NB + hd * 256 + 2 * i) = pk2(q1 * cs - q2 * sn, q1 * sn + q2 * cs);
            *(unsigned*)(HB + (size_t)m * NB + 1024 + hd * 256 + 2 * i) = pk2((k1 * cs - k2 * sn) * 0.0625f, (k1 * sn + k2 * cs) * 0.0625f); }
    }
}
#define XB_TMO      128
#define XB_XCNT(j)  (256  + 64 * (j))
#define XB_XSUB(j)  (1280 + 64 * (j))
#define XB_XGEN(j)  (2304 + 64 * (j))
#define XB_TOP      3328
#define XB_TOPGEN   3392
#define XCD_BAR_WORDS 3456
#define XB_SPIN_CAP (1u << 18)

__device__ __forceinline__ unsigned xb_ld(unsigned* p)              { return __hip_atomic_load(p, __ATOMIC_RELAXED, __HIP_MEMORY_SCOPE_AGENT); }
__device__ __forceinline__ unsigned xb_add(unsigned* p, unsigned v) { return __hip_atomic_fetch_add(p, v, __ATOMIC_RELAXED, __HIP_MEMORY_SCOPE_AGENT); }
__device__ __forceinline__ unsigned xb_xcc_id() { return (unsigned)__builtin_amdgcn_s_getreg((3 << 11) | 20) & 0xFu; }
#define XB_SPIN(cond, bar) do { unsigned _sp = 0; while (cond) { __builtin_amdgcn_s_sleep(1); \
    if ((++_sp & 255u) == 0u) { if (xb_ld(&(bar)[XB_TMO])) break; if (_sp > XB_SPIN_CAP) { atomicAdd(&(bar)[XB_TMO], 1u); break; } } } } while (0)

struct XcdBarrier {
    unsigned* bar; unsigned x;
    volatile LAS unsigned* st;
};

__device__ __forceinline__ XcdBarrier xcd_barrier_post(unsigned* bar, volatile LAS unsigned* st) {
    XcdBarrier b; b.bar = bar; b.x = xb_xcc_id(); b.st = st;
    if (threadIdx.x == 0) (void)xb_add(&bar[XB_XCNT(b.x)], 1u);
    return b;
}
__device__ __forceinline__ void xcd_barrier_complete(unsigned* bar, unsigned x, unsigned& nloc, unsigned& nx) {
    const unsigned G = gridDim.x * gridDim.y * gridDim.z;
    unsigned sum, cnt, mine, sp = 0u;
    for (;;) {
        sum = 0u; cnt = 0u; mine = 0u;
#pragma unroll
        for (unsigned j = 0; j < 16; ++j) { const unsigned c = xb_ld(&bar[XB_XCNT(j)]); sum += c; cnt += (c > 0u) ? 1u : 0u; mine = (j == x) ? c : mine; }
        if (sum == G) break;
        __builtin_amdgcn_s_sleep(1);
        if ((++sp & 255u) == 0u) { if (xb_ld(&bar[XB_TMO])) break; if (sp > XB_SPIN_CAP) { atomicAdd(&bar[XB_TMO], 1u); break; } }
    }
    nloc = mine > 0u ? mine : 1u; nx = cnt > 0u ? cnt : 1u;
}

__device__ __forceinline__ void xcd_barrier(const XcdBarrier& b) {
    asm volatile("s_waitcnt vmcnt(0)" ::: "memory");
    __syncthreads();
    if (threadIdx.x == 0) {
        unsigned* bar = b.bar;
        __builtin_amdgcn_s_waitcnt(0);
        unsigned nloc = b.st[0], nx = b.st[1];
        if (nloc == 0u) { xcd_barrier_complete(bar, b.x, nloc, nx); b.st[0] = nloc; b.st[1] = nx; }
        const unsigned old = xb_add(&bar[XB_XSUB(b.x)], 1u);
        const unsigned gen = old / nloc;
        if (old + 1u == (gen + 1u) * nloc) {
            __builtin_amdgcn_fence(__ATOMIC_RELEASE, "agent");
            asm volatile("s_waitcnt vmcnt(0)" ::: "memory");
            const unsigned og = xb_add(&bar[XB_TOP], 1u);
            const unsigned tg = og / nx;
            if (og + 1u == (tg + 1u) * nx) xb_add(&bar[XB_TOPGEN], 1u);
            else XB_SPIN(xb_ld(&bar[XB_TOPGEN]) == tg, bar);
            __builtin_amdgcn_fence(__ATOMIC_ACQUIRE, "agent");
            xb_add(&bar[XB_XGEN(b.x)], 1u);
            asm volatile("s_waitcnt vmcnt(0)" ::: "memory");
        } else {
            XB_SPIN(xb_ld(&bar[XB_XGEN(b.x)]) == gen, bar);
            __builtin_amdgcn_fence(__ATOMIC_ACQUIRE, "agent");
            asm volatile("s_waitcnt vmcnt(0)" ::: "memory");
        }
    }
    __syncthreads();
}

__device__ __forceinline__ void sub_barrier(unsigned* ctr, unsigned target) {
    asm volatile("s_waitcnt vmcnt(0)" ::: "memory");
    __syncthreads();
    if (threadIdx.x == 0) {
        __builtin_amdgcn_fence(__ATOMIC_RELEASE, "agent");
        asm volatile("s_waitcnt vmcnt(0)" ::: "memory");
        __hip_atomic_fetch_add(ctr, 1u, __ATOMIC_RELAXED, __HIP_MEMORY_SCOPE_AGENT);
        while (__hip_atomic_load(ctr, __ATOMIC_RELAXED, __HIP_MEMORY_SCOPE_AGENT) < target) __builtin_amdgcn_s_sleep(2);
        __builtin_amdgcn_fence(__ATOMIC_ACQUIRE, "agent");
        asm volatile("s_waitcnt vmcnt(0)" ::: "memory");
    }
    __syncthreads();
}

struct Prep { f16b *r, *x, *km, *v, *kk, *b; float* bon; };
__device__ __forceinline__ Prep prep_ptrs(Frame& F) { Prep p; f16b* o = (f16b*)F.out; const size_t S = (size_t)M * DR;
    p.r = o; p.x = o + S; p.km = o + 2 * S; p.v = o + 3 * S; p.kk = (f16b*)(F.ws + WS_P5); p.b = (f16b*)(F.ws + WS_P6); p.bon = (float*)(F.ws + WS_BON); return p; }
__device__ __forceinline__ void p2c_rwkv_prep(Frame& F, const Args& a) {
    const bf16* HA = (const bf16*)(F.ws + WS_HA); const f16b* LRW = (const f16b*)(F.ws + WS_LRW); const f16b* LRA = (const f16b*)(F.ws + WS_LRA);
    const Prep P = prep_ptrs(F);
    const int qd = F.gw & 3, c0 = 256 * qd + 4 * F.lane, hd = c0 >> 6;
    const f32x4 mu_r = *(const f32x4*)(a.in[2] + c0), mu_k = *(const f32x4*)(a.in[2] + 1024 + c0), mu_v = *(const f32x4*)(a.in[2] + 2048 + c0);
    const f32x4 w0 = *(const f32x4*)(a.in[3] + c0), a0 = *(const f32x4*)(a.in[5] + c0), k_k = *(const f32x4*)(a.in[8] + c0), k_a = *(const f32x4*)(a.in[9] + c0), r_k = *(const f32x4*)(a.in[10] + c0);
    const int NI = F.NGW >> 2;
#pragma unroll 4
    for (int m = F.gw >> 2; m < M; m += NI) {
        const int t = m & (T - 1); const bf16* row = HA + (size_t)m * NA + c0; const size_t o = (size_t)m * DR + c0;
        const u32x2 cr = *(const u32x2*)(row), ck = *(const u32x2*)(row + 1024), cv = *(const u32x2*)(row + 2048);
        u32x2 pr = (u32x2){0u, 0u}, pk = pr, pv = pr;
        if (t > 0) { pr = *(const u32x2*)(row - NA); pk = *(const u32x2*)(row - NA + 1024); pv = *(const u32x2*)(row - NA + 2048); }
        const u32x2 lw = __builtin_nontemporal_load((const u32x2*)(LRW + o)), la = __builtin_nontemporal_load((const u32x2*)(LRA + o));
        float r[4], k[4], v[4], x[4], as[4], kk[4], km[4]; float n2 = 0.f, bon = 0.f;
#pragma unroll
        for (int e = 0; e < 4; ++e) {
            const unsigned wr_ = cr[e >> 1], wk_ = ck[e >> 1], wv_ = cv[e >> 1], qr_ = pr[e >> 1], qk_ = pk[e >> 1], qv_ = pv[e >> 1];
            const float hr = (e & 1) ? bf_hi(wr_) : bf_lo(wr_), hk = (e & 1) ? bf_hi(wk_) : bf_lo(wk_), hv = (e & 1) ? bf_hi(wv_) : bf_lo(wv_);
            const float gr = (e & 1) ? bf_hi(qr_) : bf_lo(qr_), gk = (e & 1) ? bf_hi(qk_) : bf_lo(qk_), gv = (e & 1) ? bf_hi(qv_) : bf_lo(qv_);
            r[e] = hr + (gr - hr) * mu_r[e]; k[e] = hk + (gk - hk) * mu_k[e]; v[e] = hv + (gv - hv) * mu_v[e];
            const float wpre = w0[e] + ((e & 1) ? h_hi(lw[e >> 1]) : h_lo(lw[e >> 1])), apre = a0[e] + ((e & 1) ? h_hi(la[e >> 1]) : h_lo(la[e >> 1]));
            const float z = -wpre; const float sp = fmaxf(z, 0.f) + __logf(1.f + __expf(-fabsf(z)));
            const float ew = __expf(-sp - 0.5f); x[e] = 1.f - __expf(-ew);
            as[e] = sigmoidf_(apre); kk[e] = k[e] * k_k[e]; n2 += kk[e] * kk[e];
            km[e] = k[e] * (1.f + (as[e] - 1.f) * k_a[e]); bon += r[e] * km[e] * r_k[e]; }
        n2 = row16_sum(n2); bon = row16_sum(bon);
        const float inv = 1.f / fmaxf(sqrtf(n2), 1e-12f);
#pragma unroll
        for (int e = 0; e < 4; ++e) kk[e] *= inv;
        __builtin_nontemporal_store((u32x2){pkh(r[0], r[1]), pkh(r[2], r[3])}, (u32x2*)(P.r + o)); __builtin_nontemporal_store((u32x2){pkh(x[0], x[1]), pkh(x[2], x[3])}, (u32x2*)(P.x + o));
        __builtin_nontemporal_store((u32x2){pkh(km[0], km[1]), pkh(km[2], km[3])}, (u32x2*)(P.km + o)); __builtin_nontemporal_store((u32x2){pkh(v[0], v[1]), pkh(v[2], v[3])}, (u32x2*)(P.v + o));
        __builtin_nontemporal_store((u32x2){pkh(kk[0], kk[1]), pkh(kk[2], kk[3])}, (u32x2*)(P.kk + o)); __builtin_nontemporal_store((u32x2){pkh(kk[0] * as[0], kk[1] * as[1]), pkh(kk[2] * as[2], kk[3] * as[3])}, (u32x2*)(P.b + o));
        if ((F.lane & 15) == 0) P.bon[(size_t)m * 16 + hd] = bon;
    }
}
constexpr int RC = 32;
constexpr int RB_VEC = 0, RB_SCL = 16 * 9 * 64, RB_V = RB_SCL + 16 * 12, RB_Y = RB_V + RC * 16, RB_FLOATS = RB_Y + RC * 256;
static_assert(2 * RB_FLOATS * 4 <= LDS_BYTES, "rwkv scan LDS");
__device__ __forceinline__ void rwkv_scan_unit(Frame& F, int unit) {
    const int bh = unit >> 2, rg = unit & 3, b = bh >> 4, h = bh & 15; const size_t m0 = (size_t)b * T; const int ch0 = h * 64;
    const Prep P = prep_ptrs(F); bf16* MIX = (bf16*)(F.ws + WS_MIX);
    LAS float* L = (LAS float*)F.lds;
    constexpr int NCH = T / RC;
    if (F.wave >= 4) {
        const int ht = F.tid - 256, pp = ht >> 4, c4 = (ht & 15) * 4, s = ht >> 3, c8 = ht & 7;
        u32x2 qr[2][2], qx[2][2], qk[2][2], qa[2][2], qb[2][2]; unsigned qv[2];
#define RW_LOAD(c, S_) do { \
        _Pragma("unroll") for (int u_ = 0; u_ < 2; ++u_) { const size_t o_ = (m0 + (size_t)(c) * RC + 2 * pp + u_) * DR + ch0 + c4; \
            qr[S_][u_] = *(const u32x2*)(P.r + o_); qx[S_][u_] = *(const u32x2*)(P.x + o_); qk[S_][u_] = *(const u32x2*)(P.km + o_); qa[S_][u_] = *(const u32x2*)(P.kk + o_); qb[S_][u_] = *(const u32x2*)(P.b + o_); } \
        qv[S_] = *(const unsigned*)(P.v + (m0 + (size_t)(c) * RC + s) * DR + ch0 + 16 * rg + 2 * c8); } while (0)
#define RW_WRITE(buf, S_) do { LAS float* B_ = L + (buf) * RB_FLOATS; float c1_ = 0.f, c2_ = 0.f, br0_ = 0.f, kr0_ = 0.f, d1_ = 0.f, d2_ = 0.f, br1_ = 0.f, kr1_ = 0.f; \
        f32x4 o_[9]; \
        _Pragma("unroll") for (int e_ = 0; e_ < 4; ++e_) { \
            const unsigned wr0u = qr[S_][0][e_ >> 1], wx0u = qx[S_][0][e_ >> 1], wk0u = qk[S_][0][e_ >> 1], wa0u = qa[S_][0][e_ >> 1], wb0u = qb[S_][0][e_ >> 1]; \
            const unsigned wr1u = qr[S_][1][e_ >> 1], wx1u = qx[S_][1][e_ >> 1], wk1u = qk[S_][1][e_ >> 1], wa1u = qa[S_][1][e_ >> 1], wb1u = qb[S_][1][e_ >> 1]; \
            const float r0 = (e_ & 1) ? h_hi(wr0u) : h_lo(wr0u), w0 = 1.f - ((e_ & 1) ? h_hi(wx0u) : h_lo(wx0u)), k0 = (e_ & 1) ? h_hi(wk0u) : h_lo(wk0u), a0 = (e_ & 1) ? h_hi(wa0u) : h_lo(wa0u), b0 = (e_ & 1) ? h_hi(wb0u) : h_lo(wb0u); \
            const float r1 = (e_ & 1) ? h_hi(wr1u) : h_lo(wr1u), w1 = 1.f - ((e_ & 1) ? h_hi(wx1u) : h_lo(wx1u)), k1 = (e_ & 1) ? h_hi(wk1u) : h_lo(wk1u), a1 = (e_ & 1) ? h_hi(wa1u) : h_lo(wa1u), b1 = (e_ & 1) ? h_hi(wb1u) : h_lo(wb1u); \
            const float wr1 = w1 * r1; \
            o_[0][e_] = a0; o_[1][e_] = w0 * r0; o_[2][e_] = w0 * a1; o_[3][e_] = w0 * wr1; o_[4][e_] = w0 * w1; o_[5][e_] = k0 * w1; o_[6][e_] = b0 * w1; o_[7][e_] = k1; o_[8][e_] = b1; \
            c1_ += b0 * a1; c2_ += k0 * a1; br0_ += b0 * r0; kr0_ += k0 * r0; d1_ += b0 * wr1; d2_ += k0 * wr1; br1_ += b1 * r1; kr1_ += k1 * r1; } \
        _Pragma("unroll") for (int j_ = 0; j_ < 9; ++j_) *(LAS f32x4*)(B_ + RB_VEC + (pp * 9 + j_) * 64 + c4) = o_[j_]; \
        c1_ = row16_sum(c1_); c2_ = row16_sum(c2_); br0_ = row16_sum(br0_); kr0_ = row16_sum(kr0_); d1_ = row16_sum(d1_); d2_ = row16_sum(d2_); br1_ = row16_sum(br1_); kr1_ = row16_sum(kr1_); \
        if ((ht & 15) == 0) { *(LAS f32x4*)(B_ + RB_SCL + pp * 12) = (f32x4){c1_, c2_, br0_ * 0.0625f, kr0_ * 0.0625f}; *(LAS f32x4*)(B_ + RB_SCL + pp * 12 + 4) = (f32x4){d1_ * 0.0625f, d2_ * 0.0625f, br1_ * 0.0625f, kr1_ * 0.0625f}; } \
        *(LAS f32x2*)(B_ + RB_V + s * 16 + 2 * c8) = (f32x2){h_lo(qv[S_]), h_hi(qv[S_])}; } while (0)
#define RW_STOREY(buf, c) do { const LAS float* B_ = L + (buf) * RB_FLOATS; float y_[2]; \
        _Pragma("unroll") for (int q_ = 0; q_ < 2; ++q_) { const LAS f32x4* yp_ = (const LAS f32x4*)(B_ + RB_Y + (s * 16 + 2 * c8 + q_) * 16); \
            const f32x4 a_ = yp_[0], b_ = yp_[1], c_ = yp_[2], d_ = yp_[3]; \
            y_[q_] = ((a_.x + a_.y) + (a_.z + a_.w)) + ((b_.x + b_.y) + (b_.z + b_.w)) + (((c_.x + c_.y) + (c_.z + c_.w)) + ((d_.x + d_.y) + (d_.z + d_.w))); } \
        *(unsigned*)(MIX + (m0 + (size_t)(c) * RC + s) * D + ch0 + 16 * rg + 2 * c8) = pk2(y_[0], y_[1]); } while (0)
        RW_LOAD(0, 0); RW_WRITE(0, 0); RW_LOAD(1, 1); RW_LOAD(2, 0);
        __syncthreads();
        for (int c = 0; c < NCH; c += 2) {
            if (c + 1 < NCH) RW_WRITE(1, 1);
            if (c + 3 < NCH) RW_LOAD(c + 3, 1);
            if (c > 0) RW_STOREY(1, c - 1);
            __syncthreads();
            if (c + 2 < NCH) RW_WRITE(0, 0);
            if (c + 4 < NCH) RW_LOAD(c + 4, 0);
            RW_STOREY(0, c);
            __syncthreads();
        }
        RW_STOREY((NCH - 1) & 1, NCH - 1);
#undef RW_LOAD
#undef RW_WRITE
#undef RW_STOREY
    } else {
        const int g4 = F.lane >> 4, l = F.lane & 15, vrow = F.wave * 4 + g4;
        f32x2 Sa = (f32x2){0.f, 0.f}, Sb = (f32x2){0.f, 0.f};
        struct PairV { f32x4 v[9]; f32x4 sa, sb; float vv0, vv1; };
#define SC_LD(d, p_) do { _Pragma("unroll") for (int j_ = 0; j_ < 9; ++j_) d.v[j_] = *(const LAS f32x4*)(B + RB_VEC + ((p_) * 9 + j_) * 64 + 4 * l); \
        d.sa = *(const LAS f32x4*)(B + RB_SCL + (p_) * 12); d.sb = *(const LAS f32x4*)(B + RB_SCL + (p_) * 12 + 4); d.vv0 = B[RB_V + (2 * (p_)) * 16 + vrow]; d.vv1 = B[RB_V + (2 * (p_) + 1) * 16 + vrow]; } while (0)
#define LO2(q_) ((f32x2){(q_).x, (q_).y})
#define HI2(q_) ((f32x2){(q_).z, (q_).w})
#define SC_PAIR(d, p_) do { \
        const f32x2 t1 = Sa * LO2(d.v[0]) + Sb * HI2(d.v[0]), t2 = Sa * LO2(d.v[1]) + Sb * HI2(d.v[1]), t3 = Sa * LO2(d.v[2]) + Sb * HI2(d.v[2]), t4 = Sa * LO2(d.v[3]) + Sb * HI2(d.v[3]); \
        const float p1 = row16_sum(t1.x + t1.y), r3 = row16_sum(t3.x + t3.y); \
        const float p1n = r3 - p1 * d.sa.x + d.vv0 * d.sa.y; \
        Y[(2 * (p_)) * 256 + vrow * 16 + l] = (t2.x + t2.y) + (d.vv0 * d.sa.w - p1 * d.sa.z); \
        Y[(2 * (p_) + 1) * 256 + vrow * 16 + l] = (t4.x + t4.y) + ((d.vv0 * d.sb.y - p1 * d.sb.x) + (d.vv1 * d.sb.w - p1n * d.sb.z)); \
        const f32x2 ea = (LO2(d.v[5]) * d.vv0 - LO2(d.v[6]) * p1) + (LO2(d.v[7]) * d.vv1 - LO2(d.v[8]) * p1n), eb = (HI2(d.v[5]) * d.vv0 - HI2(d.v[6]) * p1) + (HI2(d.v[7]) * d.vv1 - HI2(d.v[8]) * p1n); \
        Sa = Sa * LO2(d.v[4]) + ea; Sb = Sb * HI2(d.v[4]) + eb; } while (0)
        __syncthreads();
        for (int c = 0; c < NCH; ++c) {
            const LAS float* B = L + (c & 1) * RB_FLOATS; LAS float* Y = L + (c & 1) * RB_FLOATS + RB_Y;
            PairV a0, a1;
            SC_LD(a0, 0);
#pragma unroll
            for (int p = 0; p < RC / 2; p += 2) {
                SC_LD(a1, p + 1);
                SC_PAIR(a0, p);
                if (p + 2 < RC / 2) SC_LD(a0, p + 2);
                SC_PAIR(a1, p + 1);
            }
            __syncthreads();
        }
#undef SC_LD
#undef SC_PAIR
#undef LO2
#undef HI2
    }
}

constexpr size_t WS_KT = 896 * MiB, WS_VT = 960 * MiB;
constexpr int TR_P = 136;
static_assert(2 * 256 * TR_P * 2 <= LDS_BYTES, "transpose LDS");
__device__ __forceinline__ float ret_lg2gamma(int h) { return log2f(1.0f - exp2f(-5.0f - (float)h)); }
__device__ __forceinline__ void ret_transpose_unit(Frame& F, int unit) {
    const int n = unit & 127, bh = unit >> 7, b = bh >> 2, h = bh & 3;
    const bf16* HB = (const bf16*)(F.ws + WS_HB); bf16* KT = (bf16*)(F.ws + WS_KT) + (size_t)unit * 32768; bf16* VT = (bf16*)(F.ws + WS_VT) + (size_t)unit * 32768;
    LAS bf16* TK = (LAS bf16*)F.lds; LAS bf16* TV = TK + 256 * TR_P;
    const int w = F.wave, cl = F.lane & 15, dq = F.lane >> 4, c = 16 * w + cl;
    const float dk = exp2f((float)(127 - c) * ret_lg2gamma(h));
    const size_t r0 = (size_t)b * T + (size_t)n * 128;
    u32x4 kreg[8], vreg[8];
#pragma unroll
    for (int i = 0; i < 8; ++i) { kreg[i] = *(const u32x4*)(HB + (r0 + c) * NB + 1024 + h * 256 + (4 * i + dq) * 8); vreg[i] = *(const u32x4*)(HB + (r0 + c) * NB + 2048 + h * 256 + (4 * i + dq) * 8); }
#pragma unroll
    for (int i = 0; i < 8; ++i) { const int d0 = (4 * i + dq) * 8;
#pragma unroll
        for (int e = 0; e < 4; ++e) { TK[(d0 + 2 * e) * TR_P + c] = (bf16)f2bf(bf_lo(kreg[i][e]) * dk); TK[(d0 + 2 * e + 1) * TR_P + c] = (bf16)f2bf(bf_hi(kreg[i][e]) * dk);
            TV[(d0 + 2 * e) * TR_P + c] = (bf16)(vreg[i][e] & 0xffffu); TV[(d0 + 2 * e + 1) * TR_P + c] = (bf16)(vreg[i][e] >> 16); } }
    __syncthreads();
#pragma unroll
    for (int i = 0; i < 8; ++i) { const int idx = i * 512 + F.tid, d = idx >> 4, chk = idx & 15;
        *(u32x4*)(KT + d * 128 + 8 * chk) = *(const LAS u32x4*)(TK + d * TR_P + 8 * chk); *(u32x4*)(VT + d * 128 + 8 * chk) = *(const LAS u32x4*)(TV + d * TR_P + 8 * chk); }
    __syncthreads();
}
constexpr int KT_P = 136, RT_P = 264;
constexpr int RS_KT = 0, RS_VT = 256 * KT_P * 2, RS_RT = RS_VT + 32 * KT_P * 2, RS_END = RS_RT + 32 * RT_P * 2;
static_assert(RS_END <= LDS_BYTES, "retention scan LDS");
__device__ __forceinline__ void ret_scan_unit(Frame& F, int ru) {
    const int bh = ru >> 3, es = ru & 7, b = bh >> 2, h = bh & 3, e0 = 32 * es;
    const bf16* HB = (const bf16*)(F.ws + WS_HB); bf16* MIX = (bf16*)(F.ws + WS_MIX);
    LAS bf16* KT = (LAS bf16*)(F.lds + RS_KT); LAS bf16* VT = (LAS bf16*)(F.lds + RS_VT); LAS bf16* RT = (LAS bf16*)(F.lds + RS_RT);
    const float lg = ret_lg2gamma(h); const float g128 = exp2f(128.f * lg);
    const int w = F.wave, lane = F.lane, cl = lane & 15, dq = lane >> 4;
    const bf16* KTg = (const bf16*)(F.ws + WS_KT) + (size_t)bh * 128 * 32768; const bf16* VTg = (const bf16*)(F.ws + WS_VT) + (size_t)bh * 128 * 32768;
    for (int i = F.tid; i < 32 * RT_P / 2; i += 512) ((LAS unsigned*)RT)[i] = 0u;
    pg8::f32x4 acc[2][2];
#pragma unroll
    for (int i = 0; i < 2; ++i)
#pragma unroll
        for (int j = 0; j < 2; ++j) acc[i][j] = (pg8::f32x4){0.f, 0.f, 0.f, 0.f};
    u32x4 kreg[8], vreg, qreg[8];
    const size_t mb = (size_t)b * T;
#define RS_LOAD(n) do { const size_t r0_ = mb + (size_t)(n) * 128; \
        _Pragma("unroll") for (int i_ = 0; i_ < 8; ++i_) { const int idx_ = i_ * 512 + F.tid; kreg[i_] = *(const u32x4*)(KTg + (size_t)(n) * 32768 + (idx_ >> 4) * 128 + 8 * (idx_ & 15)); } \
        vreg = *(const u32x4*)(VTg + (size_t)(n) * 32768 + (e0 + (F.tid >> 4)) * 128 + 8 * (F.tid & 15)); \
        _Pragma("unroll") for (int k_ = 0; k_ < 8; ++k_) qreg[k_] = *(const u32x4*)(HB + (r0_ + 16 * w + cl) * NB + h * 256 + 32 * k_ + dq * 8); } while (0)
    RS_LOAD(0);
    for (int n = 0; n < T / 128; ++n) {
#pragma unroll
        for (int i = 0; i < 8; ++i) { const int idx = i * 512 + F.tid; *(LAS u32x4*)(KT + (idx >> 4) * KT_P + 8 * (idx & 15)) = kreg[i]; }
        *(LAS u32x4*)(VT + (F.tid >> 4) * KT_P + 8 * (F.tid & 15)) = vreg;
        __syncthreads();
        bf16x8 qcur[8];
#pragma unroll
        for (int k_ = 0; k_ < 8; ++k_) qcur[k_] = __builtin_bit_cast(bf16x8, qreg[k_]);
        if (n + 1 < T / 128) RS_LOAD(n + 1);
        { pg8::f32x4 cx[2] = {(pg8::f32x4){0.f, 0.f, 0.f, 0.f}, (pg8::f32x4){0.f, 0.f, 0.f, 0.f}};
#pragma unroll
          for (int ks = 0; ks < 8; ++ks)
#pragma unroll
              for (int et = 0; et < 2; ++et) { const bf16x8 Bf = *(const LAS bf16x8*)(RT + (16 * et + cl) * RT_P + 32 * ks + dq * 8);
                  cx[et] = __builtin_amdgcn_mfma_f32_16x16x32_bf16(qcur[ks], Bf, cx[et], 0, 0, 0); }
#pragma unroll
          for (int r = 0; r < 4; ++r) { const int c = 16 * w + dq * 4 + r; const float qd = exp2f((float)(c + 1) * lg);
#pragma unroll
              for (int et = 0; et < 2; ++et) MIX[(mb + (size_t)n * 128 + c) * D + DR + h * 256 + e0 + 16 * et + cl] = (bf16)f2bf(cx[et][r] * qd); } }
#pragma unroll
        for (int dt = 0; dt < 2; ++dt)
#pragma unroll
            for (int et = 0; et < 2; ++et) acc[dt][et] = acc[dt][et] * g128;
#pragma unroll
        for (int kc = 0; kc < 4; ++kc) { bf16x8 Af[2], Bf[2];
#pragma unroll
            for (int dt = 0; dt < 2; ++dt) Af[dt] = *(const LAS bf16x8*)(KT + (32 * w + 16 * dt + cl) * KT_P + 32 * kc + dq * 8);
#pragma unroll
            for (int et = 0; et < 2; ++et) Bf[et] = *(const LAS bf16x8*)(VT + (16 * et + cl) * KT_P + 32 * kc + dq * 8);
#pragma unroll
            for (int dt = 0; dt < 2; ++dt)
#pragma unroll
                for (int et = 0; et < 2; ++et) acc[dt][et] = __builtin_amdgcn_mfma_f32_16x16x32_bf16(Af[dt], Bf[et], acc[dt][et], 0, 0, 0); }
        __syncthreads();
#pragma unroll
        for (int dt = 0; dt < 2; ++dt)
#pragma unroll
            for (int et = 0; et < 2; ++et) { u32x2 p; p.x = pk2(acc[dt][et][0], acc[dt][et][1]); p.y = pk2(acc[dt][et][2], acc[dt][et][3]);
                *(LAS u32x2*)(RT + (16 * et + cl) * RT_P + 32 * w + 16 * dt + dq * 4) = p; }
    }
#undef RS_LOAD
    __syncthreads();
}
constexpr int KS_P = 264, VT_P = 136, PW_P = 136;
constexpr int RI_KS = 0, RI_VT = 128 * KS_P * 2, RI_END = RI_VT + 256 * VT_P * 2;
static_assert(RI_END <= LDS_BYTES && 8 * 16 * PW_P * 2 <= RI_VT, "retention intra LDS");
__device__ __forceinline__ void ret_intra_unit(Frame& F, const Args& a, int unit) {
    const int n = unit & 127, bh = unit >> 7, b = bh >> 2, h = bh & 3;
    const bf16* HB = (const bf16*)(F.ws + WS_HB); bf16* MIX = (bf16*)(F.ws + WS_MIX);
    LAS bf16* KS = (LAS bf16*)(F.lds + RI_KS); LAS bf16* VT = (LAS bf16*)(F.lds + RI_VT);
    const int w = F.wave, lane = F.lane, cl = lane & 15, dq = lane >> 4;
    const float lg = ret_lg2gamma(h);
    const size_t r0 = (size_t)b * T + (size_t)n * 128;
#pragma unroll
    for (int i = 0; i < 8; ++i) { const int idx = i * 512 + F.tid, c = idx >> 5, chk = idx & 31;
        *(LAS u32x4*)(KS + c * KS_P + 8 * chk) = *(const u32x4*)(HB + (r0 + c) * NB + 1024 + h * 256 + 8 * chk); }
    { const bf16* VTg = (const bf16*)(F.ws + WS_VT) + (size_t)unit * 32768;
#pragma unroll
      for (int i = 0; i < 8; ++i) { const int idx = i * 512 + F.tid, e = idx >> 4, chk = idx & 15; *(LAS u32x4*)(VT + e * VT_P + 8 * chk) = *(const u32x4*)(VTg + e * 128 + 8 * chk); } }
    bf16x8 qf[8];
#pragma unroll
    for (int ks = 0; ks < 8; ++ks) qf[ks] = __builtin_bit_cast(bf16x8, *(const u32x4*)(HB + (r0 + 16 * w + cl) * NB + h * 256 + 32 * ks + dq * 8));
    __syncthreads();
    pg8::f32x4 s[8];
#pragma unroll
    for (int mt = 0; mt < 8; ++mt) { s[mt] = (pg8::f32x4){0.f, 0.f, 0.f, 0.f};
        if (mt <= w) {
#pragma unroll
            for (int ks = 0; ks < 8; ++ks) { const bf16x8 Bf = *(const LAS bf16x8*)(KS + (16 * mt + cl) * KS_P + 32 * ks + dq * 8);
                s[mt] = __builtin_amdgcn_mfma_f32_16x16x32_bf16(qf[ks], Bf, s[mt], 0, 0, 0); } } }
    __syncthreads();
    LAS bf16* PW = (LAS bf16*)(F.lds) + w * 16 * PW_P;
#pragma unroll
    for (int mt = 0; mt < 8; ++mt)
#pragma unroll
        for (int r = 0; r < 4; ++r) { const int cc = 16 * w + dq * 4 + r, mm = 16 * mt + cl; const float dm = (mm <= cc) ? exp2f((float)(cc - mm) * lg) : 0.f;
            PW[(dq * 4 + r) * PW_P + mm] = (bf16)f2bf(s[mt][r] * dm); }
    LDS_WAIT(); asm volatile("" ::: "memory");
    pg8::f32x4 o[16];
#pragma unroll
    for (int et = 0; et < 16; ++et) o[et] = (pg8::f32x4){0.f, 0.f, 0.f, 0.f};
#pragma unroll
    for (int kc = 0; kc < 4; ++kc) if (kc <= (w >> 1)) { const bf16x8 Af = *(const LAS bf16x8*)(PW + cl * PW_P + 32 * kc + dq * 8);
#pragma unroll
        for (int et = 0; et < 16; ++et) { const bf16x8 Bf = *(const LAS bf16x8*)(VT + (16 * et + cl) * VT_P + 32 * kc + dq * 8);
            o[et] = __builtin_amdgcn_mfma_f32_16x16x32_bf16(Af, Bf, o[et], 0, 0, 0); } }
    const float* gnw = a.in[13] + h * 256;
#pragma unroll
    for (int r = 0; r < 4; ++r) { const size_t row = r0 + 16 * w + dq * 4 + r; bf16* mp = MIX + row * D + DR + h * 256 + cl; const bf16* gp = HB + row * NB + 3072 + h * 256 + cl;
        float sum = 0.f;
#pragma unroll
        for (int et = 0; et < 16; ++et) { o[et][r] += bf1(mp[16 * et]); sum += o[et][r]; }
        const float mean = row16_sum(sum) * (1.f / 256.f); float q = 0.f;
#pragma unroll
        for (int et = 0; et < 16; ++et) { const float d = o[et][r] - mean; q += d * d; }
        const float rstd = 1.f / sqrtf(row16_sum(q) * (1.f / 256.f) + RET_GN_EPS);
#pragma unroll
        for (int et = 0; et < 16; ++et) { const float g = bf1(gp[16 * et]); const float y = (o[et][r] - mean) * rstd * gnw[16 * et + cl] * (g * sigmoidf_(g)); mp[16 * et] = (bf16)f2bf(y); } }
    __syncthreads();
}
__device__ __forceinline__ void rwkv_finalize(Frame& F, const Args& a) {
    const Prep P = prep_ptrs(F); bf16* MIX = (bf16*)(F.ws + WS_MIX); const f16b* G = (const f16b*)(F.ws + WS_G);
    const int c0 = 16 * F.lane, hd = F.lane >> 2;
    float gw_[16], gb_[16];
#pragma unroll
    for (int j = 0; j < 4; ++j) { const f32x4 x = *(const f32x4*)(a.in[11] + c0 + 4 * j), y = *(const f32x4*)(a.in[12] + c0 + 4 * j);
        gw_[4 * j] = x.x; gw_[4 * j + 1] = x.y; gw_[4 * j + 2] = x.z; gw_[4 * j + 3] = x.w; gb_[4 * j] = y.x; gb_[4 * j + 1] = y.y; gb_[4 * j + 2] = y.z; gb_[4 * j + 3] = y.w; }
    for (int m = F.gw; m < M; m += F.NGW) {
        u32x4 yv[2], vv[2], gv[2];
        yv[0] = __builtin_nontemporal_load((const u32x4*)(MIX + (size_t)m * D + c0)); yv[1] = __builtin_nontemporal_load((const u32x4*)(MIX + (size_t)m * D + c0 + 8));
        vv[0] = __builtin_nontemporal_load((const u32x4*)(P.v + (size_t)m * DR + c0)); vv[1] = __builtin_nontemporal_load((const u32x4*)(P.v + (size_t)m * DR + c0 + 8));
        gv[0] = __builtin_nontemporal_load((const u32x4*)(G + (size_t)m * DR + c0)); gv[1] = __builtin_nontemporal_load((const u32x4*)(G + (size_t)m * DR + c0 + 8));
        const float bon = P.bon[(size_t)m * 16 + hd];
        float y[16]; float s = 0.f;
#pragma unroll
        for (int j = 0; j < 8; ++j) { y[2 * j] = bf_lo(yv[j >> 2][j & 3]); y[2 * j + 1] = bf_hi(yv[j >> 2][j & 3]); s += y[2 * j] + y[2 * j + 1]; }
        s += __shfl_xor(s, 1); s += __shfl_xor(s, 2); const float mean = s * (1.f / 64.f); float q = 0.f;
#pragma unroll
        for (int j = 0; j < 16; ++j) { y[j] -= mean; q += y[j] * y[j]; }
        q += __shfl_xor(q, 1); q += __shfl_xor(q, 2); const float rstd = 1.f / sqrtf(q * (1.f / 64.f) + RWKV_GN_EPS);
        u32x4 ov[2];
#pragma unroll
        for (int j = 0; j < 8; ++j) { const unsigned vw = vv[j >> 2][j & 3], gw2 = gv[j >> 2][j & 3];
            const float o0 = (y[2 * j] * rstd * gw_[2 * j] + gb_[2 * j] + bon * h_lo(vw)) * h_lo(gw2);
            const float o1 = (y[2 * j + 1] * rstd * gw_[2 * j + 1] + gb_[2 * j + 1] + bon * h_hi(vw)) * h_hi(gw2);
            ov[j >> 2][j & 3] = pk2(o0, o1); }
        *(u32x4*)(MIX + (size_t)m * D + c0) = ov[0]; *(u32x4*)(MIX + (size_t)m * D + c0 + 8) = ov[1];
    }
}

constexpr int N_PHASES = 12;
__global__ void __launch_bounds__(NWAVES * 64, 2) fwd_kernel(Args args) {
    extern __shared__ __attribute__((aligned(16))) unsigned char lds_raw[];
    Frame F;
    F.lds = (LAS unsigned char*)lds_raw; F.ws = args.ws; F.out = args.out;
    F.tid = threadIdx.x; F.lane = F.tid & 63; F.wave = __builtin_amdgcn_readfirstlane(F.tid >> 6);
    F.G = gridDim.x; F.gw = blockIdx.x * NWAVES + F.wave; F.NGW = F.G * NWAVES;
    const int lo = args.ph_lo, hi = args.ph_hi;
#define IN(k) (lo <= (k) && (k) < hi)
    unsigned nbar = 0u; unsigned* gctr = (unsigned*)(args.ws + WS_CTL) + 128;
    volatile LAS unsigned* xst = (volatile LAS unsigned*)(F.lds + LDS_BYTES - 64);
    if (F.tid < 16) xst[F.tid] = 0u;
    __syncthreads();
    XcdBarrier xbar = xcd_barrier_post((unsigned*)(args.ws + WS_CTL) + 2048, xst);
#define SEAM(k) do { if (IN(k) && IN((k) + 1)) { if (args.coop == 1) { xcd_barrier(xbar); } else if (args.coop == 3) { nbar += (unsigned)F.G; sub_barrier(gctr, nbar); } else if (args.coop == 2) cg::this_grid().sync(); } } while (0)
    typedef pg8::bf16_t b16;
    if (IN(0)) { p0_prologue(F, args); } SEAM(0);
    if (IN(1)) {
        pg8::Gemm g{(const b16*)(F.ws + WS_XB), (const b16*)(F.ws + WS_WIN), M, N1A, D}; pg8::StaticOrder S; S.init(M, N1A, F.G, (int)blockIdx.x);
        pg8::EpiH16<0> E{(b16*)(F.ws + WS_HA), (b16*)(F.ws + WS_HB), (b16*)(F.ws + WS_HB), NA, NB, NB, NA, 1 << 30};
        pg8::gemm_phase<pg8::EpiH16<0>, pg8::StaticOrder, true, true>(F.lds, g, S, E);
    } SEAM(1);
    if (IN(2)) { p2a_prep(F, args); } SEAM(2);
    if (IN(3)) {
        pg8::Gemm g{(const b16*)((unsigned char*)F.out + OUT_AP), (const b16*)(F.ws + WS_WL), M, 3072, args.klora}; pg8::StaticOrder S; S.init(M, 3072, F.G, (int)blockIdx.x);
        pg8::EpiH16<2> E{(b16*)(F.ws + WS_LRW), (b16*)(F.ws + WS_LRA), (b16*)(F.ws + WS_G), DR, DR, DR, 1024, 2048};
        pg8::gemm_phase<pg8::EpiH16<2>, pg8::StaticOrder, true, true>(F.lds, g, S, E);
    } SEAM(3);
    if (IN(4)) { p2c_rwkv_prep(F, args); } SEAM(4);
    if (IN(5)) {
        if (blockIdx.x < 128) { rwkv_scan_unit(F, (int)blockIdx.x); }
        else {
            const int bb = (int)blockIdx.x - 128; unsigned* ctr = (unsigned*)(F.ws + WS_CTL) + 64;
            {
                pg8::Gemm g{(const b16*)(F.ws + WS_XB), (const b16*)(F.ws + WS_WIN) + (size_t)N1A * D, M, 6400 - N1A, D}; pg8::StaticOrder S; S.init(M, 6400 - N1A, 128, bb);
                pg8::EpiH16<0> E{(b16*)(F.ws + WS_HB) + (N1A - NA), (b16*)(F.ws + WS_HB), (b16*)(F.ws + WS_HB), NB, NB, NB, 1 << 30, 1 << 30};
                pg8::gemm_phase<pg8::EpiH16<0>, pg8::StaticOrder, true, true>(F.lds, g, S, E);
            }
            sub_barrier(ctr, 128u);
            ret_rotary(F, bb * NWAVES + F.wave, 128 * NWAVES);
            sub_barrier(ctr, 256u);
            for (int u = bb; u < 1024; u += 128) ret_transpose_unit(F, u);
            sub_barrier(ctr, 384u);
            if (bb < 64) ret_scan_unit(F, bb);
            else {
                p0_late_weights(F, args, (bb - 64) * NWAVES + F.wave, 64 * NWAVES);
                __syncthreads();
                pg8::Gemm g{(const b16*)(F.ws + WS_XB), (const b16*)(F.ws + WS_WIN) + (size_t)6400 * D, M, 1024, D}; pg8::StaticOrder S; S.init(M, 1024, 64, bb - 64);
                pg8::EpiH16<0> E{(b16*)(F.ws + WS_HB) + 3072, (b16*)(F.ws + WS_HB), (b16*)(F.ws + WS_HB), NB, NB, NB, 1 << 30, 1 << 30};
                pg8::gemm_phase<pg8::EpiH16<0>, pg8::StaticOrder, true, true>(F.lds, g, S, E);
            }
            sub_barrier(ctr, 512u);
        }
    }
    if (IN(5)) { if (blockIdx.x >= 128) { for (int u = (int)blockIdx.x - 128; u < 1024; u += 128) ret_intra_unit(F, args, u); } } SEAM(5);
    if (IN(6)) { rwkv_finalize(F, args); } SEAM(6);
    if (IN(7)) {
        pg8::Gemm g{(const b16*)(F.ws + WS_MIX), (const b16*)(F.ws + WS_WO), M, D, D}; pg8::StaticOrder S; S.init(M, D, F.G, (int)blockIdx.x);
        pg8::EpiH16<0> E{(b16*)(F.ws + WS_HB), (b16*)(F.ws + WS_HB), (b16*)(F.ws + WS_HB), D, D, D, 1 << 30, 1 << 30};
        pg8::gemm_phase<pg8::EpiH16<0>, pg8::StaticOrder, true, true>(F.lds, g, S, E);
    } SEAM(7);
    if (IN(8)) { ln_pass<false>(F, args.in[0], (const bf16*)(F.ws + WS_HB), nullptr, (bf16*)(F.ws + WS_X1B), args.in[15], args.in[16]); } SEAM(8);
    if (IN(9)) {
        pg8::Gemm g{(const b16*)(F.ws + WS_X1B), (const b16*)(F.ws + WS_WUP), M, DFF, D}; pg8::StaticOrder S; S.init(M, DFF, F.G, (int)blockIdx.x);
        pg8::EpiH16<1> E{(b16*)(F.ws + WS_U), (b16*)(F.ws + WS_U), (b16*)(F.ws + WS_U), DFF, DFF, DFF, 1 << 30, 1 << 30};
        pg8::gemm_phase<pg8::EpiH16<1>, pg8::StaticOrder, true, true>(F.lds, g, S, E);
    } SEAM(9);
    if (IN(10)) {
        pg8::Gemm g{(const b16*)(F.ws + WS_U), (const b16*)(F.ws + WS_WDN), M, D, DFF}; pg8::StaticOrder S; S.init(M, D, F.G, (int)blockIdx.x);
        pg8::EpiH16<0> E{(b16*)(F.ws + WS_KT), (b16*)(F.ws + WS_KT), (b16*)(F.ws + WS_KT), D, D, D, 1 << 30, 1 << 30};
        pg8::gemm_phase<pg8::EpiH16<0>, pg8::StaticOrder, true, true>(F.lds, g, S, E);
    } SEAM(10);
    if (IN(11)) { ln_pass<true>(F, (const bf16*)(F.ws + WS_X1B), (const bf16*)(F.ws + WS_KT), F.out, nullptr, args.in[19], args.in[20]); }
#undef IN
#undef SEAM
}

extern "C" void kernel_launch(void* const* d_in, const int* in_sizes, int n_in, void* d_out, int out_size, void* d_ws, size_t ws_size, hipStream_t stream) {
    static int grid = 0;
    if (grid == 0) {
        if (n_in != 21 || in_sizes[0] != M * D || out_size != M * D || ws_size < WS_END) { fprintf(stderr, "kernel_launch: unexpected shapes: n_in %d in0 %d out %d ws %zu\n", n_in, n_in > 0 ? in_sizes[0] : -1, out_size, ws_size); grid = -1; return; }
        int dev = 0, cus = 0;
        if (hipGetDevice(&dev) != hipSuccess || hipDeviceGetAttribute(&cus, hipDeviceAttributeMultiprocessorCount, dev) != hipSuccess) { grid = -1; return; }
        if (hipFuncSetAttribute((const void*)fwd_kernel, hipFuncAttributeMaxDynamicSharedMemorySize, LDS_BYTES) != hipSuccess) { fprintf(stderr, "kernel_launch: hipFuncSetAttribute failed\n"); grid = -1; return; }
        (void)hipGetLastError();
        if (cus < 256) { fprintf(stderr, "kernel_launch: this kernel splits phase 5 over exactly 256 co-resident workgroups; device has %d CUs\n", cus); grid = -1; return; }
        grid = 256;
    }
    if (grid < 0) return;
    (void)hipMemsetAsync(d_ws, 0, 32768, stream);
    Args a{};
    for (int i = 0; i < 21; ++i) a.in[i] = (const float*)d_in[i];
    a.out = (float*)d_out; a.ws = (unsigned char*)d_ws; a.klora = NLORA;
    a.ph_lo = 0; a.ph_hi = N_PHASES; a.coop = 1;
    void* kargs[] = {&a};
    hipError_t e = hipLaunchCooperativeKernel((const void*)fwd_kernel, dim3(grid), dim3(NWAVES * 64), kargs, LDS_BYTES, stream);
    if (e != hipSuccess) fprintf(stderr, "kernel_launch: cooperative launch failed: %s (grid %d)\n", hipGetErrorString(e), grid);
}
```

```cpp
#include <hip/hip_runtime.h>
#include <hip/hip_cooperative_groups.h>
#include <cstdio>
#include <cstdint>
namespace cg = cooperative_groups;
namespace pg8 {
#define PG8_LAS __attribute__((address_space(3)))
typedef unsigned short bf16_t;
typedef short bf16x8 __attribute__((ext_vector_type(8)));
typedef float f32x4 __attribute__((ext_vector_type(4)));
typedef unsigned u32x4 __attribute__((ext_vector_type(4)));
constexpr int BM = 256, BK = 64, HALF = 128, HTB = HALF * BK * 2  , STAGE_BYTES = 8 * HTB, NXCD = 8, WGM = 8;

__host__ __device__ __forceinline__ int lds_byte(int r, int c) { const int st = (r >> 4) * 2 + (c >> 5), rr = r & 15, cc = c & 31, ob = rr * 64 + cc * 2; return st * 1024 + (ob ^ (((ob >> 9) & 1) << 5)); }
__host__ __device__ __forceinline__ void stage_rc(int b, int& R, int& C) { const int st = b / 1024, sb = b % 1024, swz = sb ^ (((sb >> 9) & 1) << 5); R = (st >> 1) * 16 + swz / 64; C = (st & 1) * 32 + (swz % 64) / 2; }
__host__ __device__ __forceinline__ int perm32(int rho) { const int n = rho >> 4, i = rho & 15; return 8 * (i >> 2) + 4 * n + (i & 3); }

struct Unit { int pm, pn; };
struct Gemm { const bf16_t* A; const bf16_t* Bt; int M, N, K; };

struct StaticOrder {
    int nM, nN, nwg, G, c;
    __host__ __device__ void init(int M, int N, int G_, int c_) { nM = M / BM; nN = N / BM; nwg = nM * nN; G = G_; c = c_; }
    __host__ __device__ bool next(int i, Unit& u) const {
        const long L = (long)i * G + c; if (L >= nwg) return false;
        int wgid = (int)L; { const int q = nwg / NXCD, r = nwg % NXCD, xcd = wgid % NXCD, off = wgid / NXCD; wgid = (xcd < r ? xcd * (q + 1) : r * (q + 1) + (xcd - r) * q) + off; }
        const int nig = WGM * nN, gid = wgid / nig, fm = gid * WGM, gsz = (nM - fm) < WGM ? (nM - fm) : WGM;
        u.pm = fm + ((wgid % nig) % gsz); u.pn = (wgid % nig) / gsz; return true;
    }
    __device__ __forceinline__ void a_ready(const Unit&) const {}
    __device__ __forceinline__ void done(const Unit&) const {}
};

__device__ __forceinline__ unsigned cvt_pk_bf16(float lo, float hi) { unsigned r; asm volatile("v_cvt_pk_bf16_f32 %0, %1, %2" : "=v"(r) : "v"(lo), "v"(hi)); return r; }
typedef _Float16 f16x2_t __attribute__((ext_vector_type(2)));
__device__ __forceinline__ unsigned cvt_pk_f16(float lo, float hi) { f16x2_t v; v.x = (_Float16)lo; v.y = (_Float16)hi; return __builtin_bit_cast(unsigned, v); }
template <int MODE> struct EpiH16 {
    static constexpr bool PERM = true, AFTER_DRAIN = false;
    bf16_t* O0; bf16_t* O1; bf16_t* O2; int ld0, ld1, ld2, split0, split1;
    __device__ __forceinline__ void operator()(const f32x4 (&acc)[2][2][4][2], const Unit& u, int wr, int wc, int fr, int fq) const {
        const int row0 = u.pm * BM + wr * 64 + fr; int colt = u.pn * BM; bf16_t* base = O0; int ldc = ld0;
        if (colt >= split1) { base = O2; ldc = ld2; colt -= split1; } else if (colt >= split0) { base = O1; ldc = ld1; colt -= split0; }
        const int col0 = colt + wc * 32 + 8 * fq;
#pragma unroll
        for (int ai = 0; ai < 2; ++ai)
#pragma unroll
            for (int m = 0; m < 4; ++m) { bf16_t* rowp = base + (size_t)(row0 + ai * HALF + m * 16) * ldc + col0;
#pragma unroll
                for (int bj = 0; bj < 2; ++bj) { f32x4 v0 = acc[ai][bj][m][0], v1 = acc[ai][bj][m][1];
                    if (MODE == 1) {
#pragma unroll
                        for (int e = 0; e < 4; ++e) { float a = fmaxf(v0[e], 0.f), b = fmaxf(v1[e], 0.f); v0[e] = a * a; v1[e] = b * b; } }
                    u32x4 w;
                    if (MODE == 2) { w.x = cvt_pk_f16(v0[0], v0[1]); w.y = cvt_pk_f16(v0[2], v0[3]); w.z = cvt_pk_f16(v1[0], v1[1]); w.w = cvt_pk_f16(v1[2], v1[3]); }
                    else { w.x = cvt_pk_bf16(v0[0], v0[1]); w.y = cvt_pk_bf16(v0[2], v0[3]); w.z = cvt_pk_bf16(v1[0], v1[1]); w.w = cvt_pk_bf16(v1[2], v1[3]); }
                    *(u32x4*)(rowp + bj * HALF) = w; } }
    }
};
struct EpiResid {
    static constexpr bool PERM = false, AFTER_DRAIN = false;
    const float* base; float* out; int ldc; float alpha;
    __device__ __forceinline__ void operator()(const f32x4 (&acc)[2][2][4][2], const Unit& u, int wr, int wc, int fr, int fq) const {
        const int row0 = u.pm * BM + wr * 64 + fr, col0 = u.pn * BM + wc * 32 + 4 * fq;
#pragma unroll
        for (int ai = 0; ai < 2; ++ai)
#pragma unroll
            for (int m = 0; m < 4; ++m) { const size_t off = (size_t)(row0 + ai * HALF + m * 16) * ldc + col0;
#pragma unroll
                for (int bj = 0; bj < 2; ++bj)
#pragma unroll
                    for (int n = 0; n < 2; ++n) { const size_t p = off + bj * HALF + n * 16; const f32x4 b = *(const f32x4*)(base + p); *(f32x4*)(out + p) = b * alpha + acc[ai][bj][m][n]; } }
    }
};
template <class Epi, class Sched, bool ALIGN_EPI = false, bool SP2 = false>
__device__ __forceinline__ void gemm_phase(PG8_LAS unsigned char* lds, const Gemm g, const Sched& S, const Epi& E) {
    const int tid = threadIdx.x, wid = __builtin_amdgcn_readfirstlane(tid >> 6), lane = tid & 63, wr = wid >> 2, wc = wid & 3, fr = lane & 15, fq = lane >> 4;
    const int K = g.K, nt = K / BK;
    unsigned voffA[2], voffB[2];
#pragma unroll
    for (int i = 0; i < 2; ++i) { int R, C; stage_rc(tid * 16 + i * 8192, R, C); const int Rb = Epi::PERM ? ((R & ~31) + perm32(R & 31)) : R;
        voffA[i] = (unsigned)(R * K + C) * 2u; voffB[i] = (unsigned)(Rb * K + C) * 2u; }
    const size_t kstep = (size_t)(BK * 2);
    const size_t hstep = (size_t)HALF * K * 2;
    const size_t tstep = 2 * hstep;
    const unsigned ldsw = (unsigned)wid * 1024u;
    const int aoff = lds_byte(wr * 64 + fr, fq * 8), boff = lds_byte(wc * 32 + fr, fq * 8);
#define PG8_SA(b, h) (((b) * 2 + (h)) * HTB)
#define PG8_SB(b, h) ((4 + (b) * 2 + (h)) * HTB)
#define PG8_STAGE(bufoff, gbase, voff) do { _Pragma("unroll") for (int _i = 0; _i < 2; ++_i) \
        __builtin_amdgcn_global_load_lds((const unsigned*)((const char*)(gbase) + (voff)[_i]), (PG8_LAS unsigned*)(lds + (bufoff) + ldsw + _i * 8192), 16, 0, 0); } while (0)
#define PG8_LDA(dst, b, h) do { _Pragma("unroll") for (int m = 0; m < 4; ++m) _Pragma("unroll") for (int k = 0; k < 2; ++k) dst[m][k] = *(const PG8_LAS bf16x8*)(lds + PG8_SA(b, h) + aoff + m * 2048 + k * 1024); } while (0)
#define PG8_LDB(dst, b, h) do { _Pragma("unroll") for (int n = 0; n < 2; ++n) _Pragma("unroll") for (int k = 0; k < 2; ++k) dst[n][k] = *(const PG8_LAS bf16x8*)(lds + PG8_SB(b, h) + boff + n * 2048 + k * 1024); } while (0)
#define PG8_MMA(ai, bj, At, Bt) do { __builtin_amdgcn_s_setprio(1); _Pragma("unroll") for (int m = 0; m < 4; ++m) _Pragma("unroll") for (int n = 0; n < 2; ++n) _Pragma("unroll") for (int k = 0; k < 2; ++k) \
        acc[ai][bj][m][n] = __builtin_amdgcn_mfma_f32_16x16x32_bf16(Bt[n][k], At[m][k], acc[ai][bj][m][n], 0, 0, 0); __builtin_amdgcn_s_setprio(0); } while (0)
#define PG8_WAIT_V(n) asm volatile("s_waitcnt vmcnt(" #n ")" ::: "memory")
#define PG8_WAIT_L(n) asm volatile("s_waitcnt lgkmcnt(" #n ")" ::: "memory")
#define PG8_BAR __builtin_amdgcn_s_barrier()
#define PG8_SCHED __builtin_amdgcn_sched_barrier(0)
    Unit cur, nxt; int ui = 0;
    if (!S.next(0, cur)) return;
    f32x4 acc[2][2][4][2];
#pragma unroll
    for (int a = 0; a < 2; ++a)
#pragma unroll
        for (int b = 0; b < 2; ++b)
#pragma unroll
            for (int m = 0; m < 4; ++m)
#pragma unroll
                for (int n = 0; n < 2; ++n) acc[a][b][m][n] = (f32x4){0.f, 0.f, 0.f, 0.f};
    bf16x8 At[4][2], B0[2][2], B1[2][2];
    const char* cA = (const char*)g.A + (size_t)cur.pm * tstep; const char* cB = (const char*)g.Bt + (size_t)cur.pn * tstep;
    S.a_ready(cur);
    if constexpr (SP2) {
        PG8_STAGE(PG8_SB(0, 0), cB, voffB); PG8_STAGE(PG8_SB(0, 1), cB + hstep, voffB); PG8_STAGE(PG8_SA(0, 0), cA, voffA); PG8_STAGE(PG8_SA(0, 1), cA + hstep, voffA);
        if (wr == 1) PG8_BAR;
        PG8_WAIT_V(2); PG8_BAR;
        PG8_STAGE(PG8_SB(1, 0), cB + kstep, voffB); PG8_STAGE(PG8_SA(1, 0), cA + kstep, voffA); PG8_STAGE(PG8_SB(1, 1), cB + hstep + kstep, voffB);
        PG8_WAIT_V(6); PG8_BAR;
    } else {
        PG8_STAGE(PG8_SB(0, 0), cB, voffB); PG8_STAGE(PG8_SA(0, 0), cA, voffA); PG8_STAGE(PG8_SB(0, 1), cB + hstep, voffB); PG8_STAGE(PG8_SA(0, 1), cA + hstep, voffA);
        if (wr == 1) PG8_BAR;
        PG8_WAIT_V(4); PG8_BAR;
        PG8_STAGE(PG8_SB(1, 0), cB + kstep, voffB); PG8_STAGE(PG8_SA(1, 0), cA + kstep, voffA); PG8_STAGE(PG8_SB(1, 1), cB + hstep + kstep, voffB);
        PG8_WAIT_V(6); PG8_BAR;
    }
    for (;;) {
        const bool has_next = S.next(ui + 1, nxt);
        const char* nA = has_next ? (const char*)g.A + (size_t)nxt.pm * tstep : cA; const char* nB = has_next ? (const char*)g.Bt + (size_t)nxt.pn * tstep : cB;
        for (int t = 0; t < nt; t += 2) {
            const bool last = (t == nt - 2);
            const char* a1 = cA + (size_t)(t + 1) * kstep;
            const char* a2 = last ? nA : cA + (size_t)(t + 2) * kstep; const char* b2 = last ? nB : cB + (size_t)(t + 2) * kstep;
            const char* a3 = a2 + kstep; const char* b3 = b2 + kstep;
            if (last && has_next) S.a_ready(nxt);
            if constexpr (SP2) {
            PG8_LDB(B0, 0, 0); PG8_LDB(B1, 0, 1); PG8_SCHED; PG8_LDA(At, 0, 0); PG8_STAGE(PG8_SA(1, 1), a1 + hstep, voffA);
            PG8_WAIT_V(8); PG8_WAIT_L(0); PG8_BAR; PG8_MMA(0, 0, At, B0); PG8_MMA(0, 1, At, B1); PG8_BAR; PG8_SCHED;
            PG8_LDA(At, 0, 1); PG8_STAGE(PG8_SB(0, 0), b2, voffB); PG8_STAGE(PG8_SB(0, 1), b2 + hstep, voffB); PG8_STAGE(PG8_SA(0, 0), a2, voffA);
            PG8_WAIT_V(8); PG8_WAIT_L(0); PG8_BAR; PG8_MMA(1, 0, At, B0); PG8_MMA(1, 1, At, B1); PG8_BAR; PG8_SCHED;
            PG8_LDB(B0, 1, 0); PG8_LDB(B1, 1, 1); PG8_SCHED; PG8_LDA(At, 1, 0); PG8_STAGE(PG8_SA(0, 1), a2 + hstep, voffA);
            PG8_WAIT_V(8); PG8_WAIT_L(0); PG8_BAR; PG8_MMA(0, 0, At, B0); PG8_MMA(0, 1, At, B1); PG8_BAR; PG8_SCHED;
            PG8_LDA(At, 1, 1); PG8_STAGE(PG8_SB(1, 0), b3, voffB); PG8_STAGE(PG8_SB(1, 1), b3 + hstep, voffB); PG8_STAGE(PG8_SA(1, 0), a3, voffA);
            PG8_WAIT_V(8); PG8_WAIT_L(0); PG8_BAR; PG8_MMA(1, 0, At, B0); PG8_MMA(1, 1, At, B1); PG8_BAR; PG8_SCHED;
            } else {
            PG8_LDB(B0, 0, 0); PG8_SCHED; PG8_LDA(At, 0, 0); PG8_STAGE(PG8_SA(1, 1), a1 + hstep, voffA);
            PG8_WAIT_L(8); PG8_BAR; PG8_WAIT_L(0); PG8_MMA(0, 0, At, B0); PG8_BAR; PG8_SCHED;
            PG8_LDB(B1, 0, 1); PG8_STAGE(PG8_SB(0, 0), b2, voffB);
            PG8_BAR; PG8_WAIT_L(0); PG8_MMA(0, 1, At, B1); PG8_BAR;
            PG8_LDA(At, 0, 1); PG8_STAGE(PG8_SA(0, 0), a2, voffA);
            PG8_BAR; PG8_WAIT_L(0); PG8_MMA(1, 0, At, B0); PG8_BAR; PG8_SCHED;
            PG8_STAGE(PG8_SB(0, 1), b2 + hstep, voffB);
            PG8_WAIT_V(6); PG8_BAR; PG8_MMA(1, 1, At, B1); PG8_BAR;
            PG8_LDB(B0, 1, 0); PG8_SCHED; PG8_LDA(At, 1, 0); PG8_STAGE(PG8_SA(0, 1), a2 + hstep, voffA);
            PG8_WAIT_L(8); PG8_BAR; PG8_WAIT_L(0); PG8_MMA(0, 0, At, B0); PG8_BAR; PG8_SCHED;
            PG8_LDB(B1, 1, 1); PG8_STAGE(PG8_SB(1, 0), b3, voffB);
            PG8_BAR; PG8_WAIT_L(0); PG8_MMA(0, 1, At, B1); PG8_BAR;
            PG8_LDA(At, 1, 1); PG8_STAGE(PG8_SA(1, 0), a3, voffA);
            PG8_BAR; PG8_WAIT_L(0); PG8_MMA(1, 0, At, B0); PG8_BAR; PG8_SCHED;
            PG8_STAGE(PG8_SB(1, 1), b3 + hstep, voffB);
            PG8_WAIT_V(6); PG8_BAR; PG8_MMA(1, 1, At, B1); PG8_BAR;
            }
        }
        if constexpr (ALIGN_EPI) { if (wr == 0) PG8_BAR; }
        if constexpr (!Epi::AFTER_DRAIN) { E(acc, cur, wr, wc, fr, fq); S.done(cur); }
        if (!has_next) break;
#pragma unroll
        for (int a = 0; a < 2; ++a)
#pragma unroll
            for (int b = 0; b < 2; ++b)
#pragma unroll
                for (int m = 0; m < 4; ++m)
#pragma unroll
                    for (int n = 0; n < 2; ++n) acc[a][b][m][n] = (f32x4){0.f, 0.f, 0.f, 0.f};
        cur = nxt; cA = nA; cB = nB; ++ui;
        if constexpr (ALIGN_EPI) { if (wr == 1) PG8_BAR; }
    }
    PG8_WAIT_V(0);
    if constexpr (!ALIGN_EPI) { if (wr == 0) PG8_BAR; }
    PG8_BAR;
    if constexpr (Epi::AFTER_DRAIN) { E.fused(acc, cur, wr, wc, fr, fq, lds, wid, lane); S.done(cur); }
#undef PG8_SA
#undef PG8_SB
#undef PG8_STAGE
#undef PG8_LDA
#undef PG8_LDB
#undef PG8_MMA
#undef PG8_WAIT_V
#undef PG8_WAIT_L
#undef PG8_BAR
#undef PG8_SCHED
}
}
constexpr int NWAVES = 8;
constexpr int BATCH = 2, T = 16384, M = BATCH * T, D = 2048, NIN = 7424, DFF = 8192;
constexpr int NA = 3328, NB = 4096;
constexpr int DR = 1024;
constexpr int NLORA = 256;
constexpr float LN_EPS = 1e-5f, RWKV_GN_EPS = 64e-5f, RET_GN_EPS = 1e-6f;
constexpr float ALPHA = 1.189207115002721f;
constexpr size_t MiB = 1u << 20;
constexpr size_t WS_CTL = 0, WS_WL = 1 * MiB, WS_BON = 3 * MiB, WS_WIN = 8 * MiB, WS_WO = 38 * MiB, WS_WUP = 46 * MiB, WS_WDN = 78 * MiB;
constexpr size_t WS_XB = 112 * MiB;
constexpr size_t WS_HA = 240 * MiB, WS_MIX = 240 * MiB, WS_HB = 448 * MiB;
constexpr size_t WS_G = 704 * MiB, WS_P5 = 768 * MiB, WS_P6 = 832 * MiB, WS_LRW = 896 * MiB, WS_LRA = 960 * MiB, WS_END = 1024 * MiB;
constexpr size_t WS_U = 240 * MiB, WS_X1B = 768 * MiB;
constexpr size_t OUT_AP = 0;
static_assert(WS_HA + (size_t)M * NA * 2 <= WS_HB && WS_HB + (size_t)M * NB * 2 <= WS_G && WS_U + (size_t)M * DFF * 2 <= WS_X1B, "ws map");
constexpr int N1A = NA + 256;
constexpr int LDS_BYTES = 163840;
#define LAS __attribute__((address_space(3)))
typedef unsigned short bf16;
typedef unsigned short f16b;
typedef float f32x4 __attribute__((ext_vector_type(4)));
typedef float f32x2 __attribute__((ext_vector_type(2)));
typedef unsigned u32x4 __attribute__((ext_vector_type(4)));
typedef unsigned u32x2 __attribute__((ext_vector_type(2)));
typedef short bf16x8 __attribute__((ext_vector_type(8)));
typedef _Float16 h16x2 __attribute__((ext_vector_type(2)));
typedef _Float16 h16x8 __attribute__((ext_vector_type(8)));
#define LDS_WAIT() asm volatile("s_waitcnt lgkmcnt(0)" ::: "memory")

__device__ __forceinline__ unsigned f2bf(float f) { unsigned u = __builtin_bit_cast(unsigned, f); return (u + 0x7fffu + ((u >> 16) & 1u)) >> 16; }
__device__ __forceinline__ unsigned pk2(float lo, float hi) { return f2bf(lo) | (f2bf(hi) << 16); }
__device__ __forceinline__ float bf_lo(unsigned w) { return __builtin_bit_cast(float, w << 16); }
__device__ __forceinline__ float bf_hi(unsigned w) { return __builtin_bit_cast(float, w & 0xffff0000u); }
__device__ __forceinline__ float bf1(bf16 v) { return __builtin_bit_cast(float, (unsigned)v << 16); }
__device__ __forceinline__ unsigned pkh(float lo, float hi) { h16x2 v; v.x = (_Float16)lo; v.y = (_Float16)hi; return __builtin_bit_cast(unsigned, v); }
__device__ __forceinline__ float h_lo(unsigned w) { h16x2 v = __builtin_bit_cast(h16x2, w); return (float)v.x; }
__device__ __forceinline__ float h_hi(unsigned w) { h16x2 v = __builtin_bit_cast(h16x2, w); return (float)v.y; }
__device__ __forceinline__ float wave_sum(float v) {
#pragma unroll
    for (int o = 1; o < 64; o <<= 1) v += __shfl_xor(v, o);
    return v;
}
template <int CTRL> __device__ __forceinline__ float dpp_mov(float x) { return __builtin_bit_cast(float, __builtin_amdgcn_update_dpp(0, __builtin_bit_cast(int, x), CTRL, 0xF, 0xF, true)); }
__device__ __forceinline__ float row16_sum(float x) { x += dpp_mov<0x128>(x); x += dpp_mov<0x124>(x); x += dpp_mov<0x122>(x); x += dpp_mov<0x121>(x); return x; }
__device__ __forceinline__ float fma_s(float a, float b, float c) { float d; asm("v_fma_f32 %0, %1, %2, %3" : "=v"(d) : "v"(a), "v"(b), "v"(c)); return d; }
__device__ __forceinline__ float fnma_s(float a, float b, float c) { float d; asm("v_fma_f32 %0, -%1, %2, %3" : "=v"(d) : "v"(a), "v"(b), "v"(c)); return d; }
__device__ __forceinline__ float mul_s(float a, float b) { float d; asm("v_mul_f32 %0, %1, %2" : "=v"(d) : "v"(a), "v"(b)); return d; }
__device__ __forceinline__ float sigmoidf_(float x) { return 1.f / (1.f + __expf(-x)); }

struct Args { const float* in[21]; float* out; unsigned char* ws; int ph_lo, ph_hi, coop, klora, reps, pad; };
struct Frame {
    LAS unsigned char* lds; unsigned char* ws; float* out;
    int tid, lane, wave, G, gw, NGW;
};

__device__ __forceinline__ void p0_transpose_item(const float* W, int K, int N, bf16* WT, LAS float* scr, int item, int lane, bool remap) {
    const int nblk = N / 32, kb = item / nblk, nb = item % nblk, k0 = 64 * kb, n0 = 32 * nb;
    const int nd = !remap ? n0 : (n0 < NA ? n0 : (n0 >= 6400 ? n0 - 6400 + NA : n0 + 1024));
#pragma unroll 32
    for (int i = 0; i < 32; ++i) { const int kk = 2 * i + (lane >> 5); scr[kk * 33 + (lane & 31)] = W[(size_t)(k0 + kk) * N + n0 + (lane & 31)]; }
    LDS_WAIT(); asm volatile("" ::: "memory");
    const int c = lane & 7;
#pragma unroll
    for (int j = 0; j < 4; ++j) { const int n = (lane >> 3) + 8 * j; const LAS float* s = scr + (8 * c) * 33 + n;
        u32x4 o; o.x = pk2(s[0 * 33], s[1 * 33]); o.y = pk2(s[2 * 33], s[3 * 33]); o.z = pk2(s[4 * 33], s[5 * 33]); o.w = pk2(s[6 * 33], s[7 * 33]);
        *(u32x4*)(WT + (size_t)(nd + n) * K + k0 + 8 * c) = o; }
    LDS_WAIT(); asm volatile("" ::: "memory");
}
__device__ __forceinline__ void p0_late_weights(Frame& F, const Args& a, int w, int nw) {
    LAS float* scr = (LAS float*)(F.lds + F.wave * 16384);
    const float *w_o = a.in[14], *w_up = a.in[17], *w_dn = a.in[18];
    bf16 *WO = (bf16*)(F.ws + WS_WO), *WUP = (bf16*)(F.ws + WS_WUP), *WDN = (bf16*)(F.ws + WS_WDN);
    constexpr int I_O = (D / 64) * (D / 32), I_UP = (D / 64) * (DFF / 32), I_DN = (DFF / 64) * (D / 32);
    for (int it = w; it < I_O + I_UP + I_DN; it += nw) {
        int r = it;
        if (r < I_O) { p0_transpose_item(w_o, D, D, WO, scr, r, F.lane, false); continue; } r -= I_O;
        if (r < I_UP) { p0_transpose_item(w_up, D, DFF, WUP, scr, r, F.lane, false); continue; } r -= I_UP;
        p0_transpose_item(w_dn, DFF, D, WDN, scr, r, F.lane, false);
    }
}
__device__ __forceinline__ void p0_prologue(Frame& F, const Args& a) {
    LAS float* scr = (LAS float*)(F.lds + F.wave * 16384);
    { const float* w_in = a.in[1]; bf16* WIN = (bf16*)(F.ws + WS_WIN);
      constexpr int I_IN = (D / 64) * (NIN / 32);
      for (int it = F.gw; it < I_IN; it += F.NGW) p0_transpose_item(w_in, D, NIN, WIN, scr, it, F.lane, false); }
    const int gt = F.gw * 64 + F.lane, NGT = F.NGW * 64;
    { bf16* WL = (bf16*)(F.ws + WS_WL); const float *wl = a.in[4], *al = a.in[6], *gl = a.in[7];
      for (int idx = gt; idx < 3072 * NLORA; idx += NGT) { const int n = idx >> 8, k = idx & 255; float v = 0.f;
          if (n < 1024) { if (k < 64) v = wl[k * 1024 + n]; }
          else if (n < 2048) { if (k >= 64 && k < 128) v = al[(k - 64) * 1024 + (n - 1024)]; }
          else { if (k >= 128) v = gl[(k - 128) * 1024 + (n - 2048)]; }
          WL[idx] = (bf16)f2bf(v); } }
    { const float* x = a.in[0]; bf16* XB = (bf16*)(F.ws + WS_XB);
      for (size_t c = gt; c < (size_t)M * D / 8; c += (size_t)4 * NGT) { f32x4 v0[4], v1[4];
#pragma unroll
          for (int q = 0; q < 4; ++q) { const size_t cc = c + (size_t)q * NGT; v0[q] = __builtin_nontemporal_load((const f32x4*)(x + cc * 8)); v1[q] = __builtin_nontemporal_load((const f32x4*)(x + cc * 8 + 4)); }
#pragma unroll
          for (int q = 0; q < 4; ++q) { const size_t cc = c + (size_t)q * NGT; u32x4 o; o.x = pk2(v0[q].x, v0[q].y); o.y = pk2(v0[q].z, v0[q].w); o.z = pk2(v1[q].x, v1[q].y); o.w = pk2(v1[q].z, v1[q].w); *(u32x4*)(XB + cc * 8) = o; } } }
}

template <bool IN16> __device__ __forceinline__ void ln_pass(Frame& F, const void* in, const bf16* add, float* out, bf16* outb, const float* w, const float* b) {
    for (int m0 = 2 * F.gw; m0 < M; m0 += 2 * F.NGW) {
        f32x4 v[2][8]; u32x2 av[2][8], iv[2][8]; float s[2] = {0.f, 0.f};
#pragma unroll
        for (int r = 0; r < 2; ++r) { const u32x2* ar = (const u32x2*)(add + (size_t)(m0 + r) * D) + F.lane;
#pragma unroll
            for (int j = 0; j < 8; ++j) { av[r][j] = __builtin_nontemporal_load(ar + 64 * j);
                if (IN16) iv[r][j] = __builtin_nontemporal_load((const u32x2*)((const bf16*)in + (size_t)(m0 + r) * D) + F.lane + 64 * j);
                else v[r][j] = __builtin_nontemporal_load((const f32x4*)((const float*)in + (size_t)(m0 + r) * D) + F.lane + 64 * j); } }
#pragma unroll
        for (int r = 0; r < 2; ++r) {
#pragma unroll
            for (int j = 0; j < 8; ++j) { if (IN16) v[r][j] = (f32x4){bf_lo(iv[r][j].x), bf_hi(iv[r][j].x), bf_lo(iv[r][j].y), bf_hi(iv[r][j].y)};
                v[r][j] = v[r][j] * ALPHA + (f32x4){bf_lo(av[r][j].x), bf_hi(av[r][j].x), bf_lo(av[r][j].y), bf_hi(av[r][j].y)}; s[r] += (v[r][j].x + v[r][j].y) + (v[r][j].z + v[r][j].w); }
            const float mean = wave_sum(s[r]) * (1.f / D); float s2 = 0.f;
#pragma unroll
            for (int j = 0; j < 8; ++j) { v[r][j] = v[r][j] - mean; s2 += (v[r][j].x * v[r][j].x + v[r][j].y * v[r][j].y) + (v[r][j].z * v[r][j].z + v[r][j].w * v[r][j].w); }
            const float rstd = 1.f / sqrtf(wave_sum(s2) * (1.f / D) + LN_EPS);
#pragma unroll
            for (int j = 0; j < 8; ++j) { const f32x4 wv = ((const f32x4*)w)[64 * j + F.lane], bv = ((const f32x4*)b)[64 * j + F.lane];
                const f32x4 q = v[r][j] * rstd * wv + bv;
                if (out) __builtin_nontemporal_store(q, (f32x4*)(out + (size_t)(m0 + r) * D) + F.lane + 64 * j);
                if (outb) { u32x2 p; p.x = pk2(q.x, q.y); p.y = pk2(q.z, q.w); __builtin_nontemporal_store(p, (u32x2*)(outb + (size_t)(m0 + r) * D) + 64 * j + F.lane); } }
        }
    }
}

__device__ __forceinline__ void p2a_prep(Frame& F, const Args& a) {
    const bf16* HA = (const bf16*)(F.ws + WS_HA); bf16* AP = (bf16*)((unsigned char*)F.out + OUT_AP);
    const int j0 = 4 * F.lane; const f32x4 mu4 = *(const f32x4*)(a.in[2] + 3072 + j0);
#pragma unroll 2
    for (int m = F.gw; m < M; m += F.NGW) {
        const int t = m & (T - 1);
        const u32x2 cur = *(const u32x2*)(HA + (size_t)m * NA + 3072 + j0); u32x2 prv = (u32x2){0u, 0u};
        if (t > 0) prv = *(const u32x2*)(HA + (size_t)(m - 1) * NA + 3072 + j0);
        float c[4] = {bf_lo(cur.x), bf_hi(cur.x), bf_lo(cur.y), bf_hi(cur.y)}, p[4] = {bf_lo(prv.x), bf_hi(prv.x), bf_lo(prv.y), bf_hi(prv.y)};
        const float mu[4] = {mu4.x, mu4.y, mu4.z, mu4.w}; float f[4];
#pragma unroll
        for (int e = 0; e < 4; ++e) { float v = c[e] + (p[e] - c[e]) * mu[e];
            if (F.lane < 16) v = 1.f - 2.f / (1.f + __expf(2.f * v));
            else if (F.lane >= 32) v = sigmoidf_(v);
            f[e] = v; }
        u32x2 o; o.x = pk2(f[0], f[1]); o.y = pk2(f[2], f[3]); *(u32x2*)(AP + (size_t)m * NLORA + j0) = o;
    }
}
__device__ __forceinline__ void ret_rotary(Frame& F, int w, int nw) {
    bf16* HB = (bf16*)(F.ws + WS_HB);
    const float if0 = 1.0f / exp2f((float)F.lane * (13.287712379549449f / 127.0f)), if1 = 1.0f / exp2f((float)(64 + F.lane) * (13.287712379549449f / 127.0f));
    for (int m = w; m < M; m += nw) {
        const int t = m & (T - 1);
        const float th0 = (float)t * if0, th1 = (float)t * if1;
        const double r0 = (double)th0 * 0.15915494309189535, r1 = (double)th1 * 0.15915494309189535;
        const float f0 = (float)(r0 - __builtin_rint(r0)), f1 = (float)(r1 - __builtin_rint(r1));
        const float c0 = __builtin_amdgcn_cosf(f0), s0 = __builtin_amdgcn_sinf(f0), c1 = __builtin_amdgcn_cosf(f1), s1 = __builtin_amdgcn_sinf(f1);
        unsigned qv[8], kv[8];
#pragma unroll
        for (int it = 0; it < 8; ++it) { const int p = it * 64 + F.lane, hd = p >> 7, i = p & 127;
            qv[it] = *(const unsigned*)(HB + (size_t)m * NB + hd * 256 + 2 * i); kv[it] = *(const unsigned*)(HB + (size_t)m * NB + 1024 + hd * 256 + 2 * i); }
#pragma unroll
        for (int it = 0; it < 8; ++it) { const int p = it * 64 + F.lane, hd = p >> 7, i = p & 127; const float cs = (it & 1) ? c1 : c0, sn = (it & 1) ? s1 : s0;
            const float q1 = bf_lo(qv[it]), q2 = bf_hi(qv[it]), k1 = bf_lo(kv[it]), k2 = bf_hi(kv[it]);
            *(unsigned*)(HB + (size_t)m * NB + hd * 256 + 2 * i) = pk2(q1 * cs - q2 * sn, q1 * sn + q2 * cs);
            *(unsigned*)(HB + (size_t)m * NB + 1024 + hd * 256 + 2 * i) = pk2((k1 * cs - k2 * sn) * 0.0625f, (k1 * sn + k2 * cs) * 0.0625f); }
    }
}
#define XB_TMO      128
#define XB_XCNT(j)  (256  + 64 * (j))
#define XB_XSUB(j)  (1280 + 64 * (j))
#define XB_XGEN(j)  (2304 + 64 * (j))
#define XB_TOP      3328
#define XB_TOPGEN   3392
#define XCD_BAR_WORDS 3456
#define XB_SPIN_CAP (1u << 18)

__device__ __forceinline__ unsigned xb_ld(unsigned* p)              { return __hip_atomic_load(p, __ATOMIC_RELAXED, __HIP_MEMORY_SCOPE_AGENT); }
__device__ __forceinline__ unsigned xb_add(unsigned* p, unsigned v) { return __hip_atomic_fetch_add(p, v, __ATOMIC_RELAXED, __HIP_MEMORY_SCOPE_AGENT); }
__device__ __forceinline__ unsigned xb_xcc_id() { return (unsigned)__builtin_amdgcn_s_getreg((3 << 11) | 20) & 0xFu; }
#define XB_SPIN(cond, bar) do { unsigned _sp = 0; while (cond) { __builtin_amdgcn_s_sleep(1); \
    if ((++_sp & 255u) == 0u) { if (xb_ld(&(bar)[XB_TMO])) break; if (_sp > XB_SPIN_CAP) { atomicAdd(&(bar)[XB_TMO], 1u); break; } } } } while (0)

struct XcdBarrier {
    unsigned* bar; unsigned x;
    volatile LAS unsigned* st;
};

__device__ __forceinline__ XcdBarrier xcd_barrier_post(unsigned* bar, volatile LAS unsigned* st) {
    XcdBarrier b; b.bar = bar; b.x = xb_xcc_id(); b.st = st;
    if (threadIdx.x == 0) (void)xb_add(&bar[XB_XCNT(b.x)], 1u);
    return b;
}
__device__ __forceinline__ void xcd_barrier_complete(unsigned* bar, unsigned x, unsigned& nloc, unsigned& nx) {
    const unsigned G = gridDim.x * gridDim.y * gridDim.z;
    unsigned sum, cnt, mine, sp = 0u;
    for (;;) {
        sum = 0u; cnt = 0u; mine = 0u;
#pragma unroll
        for (unsigned j = 0; j < 16; ++j) { const unsigned c = xb_ld(&bar[XB_XCNT(j)]); sum += c; cnt += (c > 0u) ? 1u : 0u; mine = (j == x) ? c : mine; }
        if (sum == G) break;
        __builtin_amdgcn_s_sleep(1);
        if ((++sp & 255u) == 0u) { if (xb_ld(&bar[XB_TMO])) break; if (sp > XB_SPIN_CAP) { atomicAdd(&bar[XB_TMO], 1u); break; } }
    }
    nloc = mine > 0u ? mine : 1u; nx = cnt > 0u ? cnt : 1u;
}

__device__ __forceinline__ void xcd_barrier(const XcdBarrier& b) {
    asm volatile("s_waitcnt vmcnt(0)" ::: "memory");
    __syncthreads();
    if (threadIdx.x == 0) {
        unsigned* bar = b.bar;
        __builtin_amdgcn_s_waitcnt(0);
        unsigned nloc = b.st[0], nx = b.st[1];
        if (nloc == 0u) { xcd_barrier_complete(bar, b.x, nloc, nx); b.st[0] = nloc; b.st[1] = nx; }
        const unsigned old = xb_add(&bar[XB_XSUB(b.x)], 1u);
        const unsigned gen = old / nloc;
        if (old + 1u == (gen + 1u) * nloc) {
            __builtin_amdgcn_fence(__ATOMIC_RELEASE, "agent");
            asm volatile("s_waitcnt vmcnt(0)" ::: "memory");
            const unsigned og = xb_add(&bar[XB_TOP], 1u);
            const unsigned tg = og / nx;
            if (og + 1u == (tg + 1u) * nx) xb_add(&bar[XB_TOPGEN], 1u);
            else XB_SPIN(xb_ld(&bar[XB_TOPGEN]) == tg, bar);
            __builtin_amdgcn_fence(__ATOMIC_ACQUIRE, "agent");
            xb_add(&bar[XB_XGEN(b.x)], 1u);
            asm volatile("s_waitcnt vmcnt(0)" ::: "memory");
        } else {
            XB_SPIN(xb_ld(&bar[XB_XGEN(b.x)]) == gen, bar);
            __builtin_amdgcn_fence(__ATOMIC_ACQUIRE, "agent");
            asm volatile("s_waitcnt vmcnt(0)" ::: "memory");
        }
    }
    __syncthreads();
}

__device__ __forceinline__ void sub_barrier(unsigned* ctr, unsigned target) {
    asm volatile("s_waitcnt vmcnt(0)" ::: "memory");
    __syncthreads();
    if (threadIdx.x == 0) {
        __builtin_amdgcn_fence(__ATOMIC_RELEASE, "agent");
        asm volatile("s_waitcnt vmcnt(0)" ::: "memory");
        __hip_atomic_fetch_add(ctr, 1u, __ATOMIC_RELAXED, __HIP_MEMORY_SCOPE_AGENT);
        while (__hip_atomic_load(ctr, __ATOMIC_RELAXED, __HIP_MEMORY_SCOPE_AGENT) < target) __builtin_amdgcn_s_sleep(2);
        __builtin_amdgcn_fence(__ATOMIC_ACQUIRE, "agent");
        asm volatile("s_waitcnt vmcnt(0)" ::: "memory");
    }
    __syncthreads();
}

struct Prep { f16b *r, *x, *km, *v, *kk, *b; float* bon; };
__device__ __forceinline__ Prep prep_ptrs(Frame& F) { Prep p; f16b* o = (f16b*)F.out; const size_t S = (size_t)M * DR;
    p.r = o; p.x = o + S; p.km = o + 2 * S; p.v = o + 3 * S; p.kk = (f16b*)(F.ws + WS_P5); p.b = (f16b*)(F.ws + WS_P6); p.bon = (float*)(F.ws + WS_BON); return p; }
__device__ __forceinline__ void p2c_rwkv_prep(Frame& F, const Args& a) {
    const bf16* HA = (const bf16*)(F.ws + WS_HA); const f16b* LRW = (const f16b*)(F.ws + WS_LRW); const f16b* LRA = (const f16b*)(F.ws + WS_LRA);
    const Prep P = prep_ptrs(F);
    const int qd = F.gw & 3, c0 = 256 * qd + 4 * F.lane, hd = c0 >> 6;
    const f32x4 mu_r = *(const f32x4*)(a.in[2] + c0), mu_k = *(const f32x4*)(a.in[2] + 1024 + c0), mu_v = *(const f32x4*)(a.in[2] + 2048 + c0);
    const f32x4 w0 = *(const f32x4*)(a.in[3] + c0), a0 = *(const f32x4*)(a.in[5] + c0), k_k = *(const f32x4*)(a.in[8] + c0), k_a = *(const f32x4*)(a.in[9] + c0), r_k = *(const f32x4*)(a.in[10] + c0);
    const int NI = F.NGW >> 2;
#pragma unroll 4
    for (int m = F.gw >> 2; m < M; m += NI) {
        const int t = m & (T - 1); const bf16* row = HA + (size_t)m * NA + c0; const size_t o = (size_t)m * DR + c0;
        const u32x2 cr = *(const u32x2*)(row), ck = *(const u32x2*)(row + 1024), cv = *(const u32x2*)(row + 2048);
        u32x2 pr = (u32x2){0u, 0u}, pk = pr, pv = pr;
        if (t > 0) { pr = *(const u32x2*)(row - NA); pk = *(const u32x2*)(row - NA + 1024); pv = *(const u32x2*)(row - NA + 2048); }
        const u32x2 lw = __builtin_nontemporal_load((const u32x2*)(LRW + o)), la = __builtin_nontemporal_load((const u32x2*)(LRA + o));
        float r[4], k[4], v[4], x[4], as[4], kk[4], km[4]; float n2 = 0.f, bon = 0.f;
#pragma unroll
        for (int e = 0; e < 4; ++e) {
            const unsigned wr_ = cr[e >> 1], wk_ = ck[e >> 1], wv_ = cv[e >> 1], qr_ = pr[e >> 1], qk_ = pk[e >> 1], qv_ = pv[e >> 1];
            const float hr = (e & 1) ? bf_hi(wr_) : bf_lo(wr_), hk = (e & 1) ? bf_hi(wk_) : bf_lo(wk_), hv = (e & 1) ? bf_hi(wv_) : bf_lo(wv_);
            const float gr = (e & 1) ? bf_hi(qr_) : bf_lo(qr_), gk = (e & 1) ? bf_hi(qk_) : bf_lo(qk_), gv = (e & 1) ? bf_hi(qv_) : bf_lo(qv_);
            r[e] = hr + (gr - hr) * mu_r[e]; k[e] = hk + (gk - hk) * mu_k[e]; v[e] = hv + (gv - hv) * mu_v[e];
            const float wpre = w0[e] + ((e & 1) ? h_hi(lw[e >> 1]) : h_lo(lw[e >> 1])), apre = a0[e] + ((e & 1) ? h_hi(la[e >> 1]) : h_lo(la[e >> 1]));
            const float z = -wpre; const float sp = fmaxf(z, 0.f) + __logf(1.f + __expf(-fabsf(z)));
            const float ew = __expf(-sp - 0.5f); x[e] = 1.f - __expf(-ew);
            as[e] = sigmoidf_(apre); kk[e] = k[e] * k_k[e]; n2 += kk[e] * kk[e];
            km[e] = k[e] * (1.f + (as[e] - 1.f) * k_a[e]); bon += r[e] * km[e] * r_k[e]; }
        n2 = row16_sum(n2); bon = row16_sum(bon);
        const float inv = 1.f / fmaxf(sqrtf(n2), 1e-12f);
#pragma unroll
        for (int e = 0; e < 4; ++e) kk[e] *= inv;
        __builtin_nontemporal_store((u32x2){pkh(r[0], r[1]), pkh(r[2], r[3])}, (u32x2*)(P.r + o)); __builtin_nontemporal_store((u32x2){pkh(x[0], x[1]), pkh(x[2], x[3])}, (u32x2*)(P.x + o));
        __builtin_nontemporal_store((u32x2){pkh(km[0], km[1]), pkh(km[2], km[3])}, (u32x2*)(P.km + o)); __builtin_nontemporal_store((u32x2){pkh(v[0], v[1]), pkh(v[2], v[3])}, (u32x2*)(P.v + o));
        __builtin_nontemporal_store((u32x2){pkh(kk[0], kk[1]), pkh(kk[2], kk[3])}, (u32x2*)(P.kk + o)); __builtin_nontemporal_store((u32x2){pkh(kk[0] * as[0], kk[1] * as[1]), pkh(kk[2] * as[2], kk[3] * as[3])}, (u32x2*)(P.b + o));
        if ((F.lane & 15) == 0) P.bon[(size_t)m * 16 + hd] = bon;
    }
}
constexpr int RC = 32;
constexpr int RB_VEC = 0, RB_SCL = 16 * 9 * 64, RB_V = RB_SCL + 16 * 12, RB_Y = RB_V + RC * 16, RB_FLOATS = RB_Y + RC * 256;
static_assert(2 * RB_FLOATS * 4 <= LDS_BYTES, "rwkv scan LDS");
__device__ __forceinline__ void rwkv_scan_unit(Frame& F, int unit) {
    const int bh = unit >> 2, rg = unit & 3, b = bh >> 4, h = bh & 15; const size_t m0 = (size_t)b * T; const int ch0 = h * 64;
    const Prep P = prep_ptrs(F); bf16* MIX = (bf16*)(F.ws + WS_MIX);
    LAS float* L = (LAS float*)F.lds;
    constexpr int NCH = T / RC;
    if (F.wave >= 4) {
        const int ht = F.tid - 256, pp = ht >> 4, c4 = (ht & 15) * 4, s = ht >> 3, c8 = ht & 7;
        u32x2 qr[2][2], qx[2][2], qk[2][2], qa[2][2], qb[2][2]; unsigned qv[2];
#define RW_LOAD(c, S_) do { \
        _Pragma("unroll") for (int u_ = 0; u_ < 2; ++u_) { const size_t o_ = (m0 + (size_t)(c) * RC + 2 * pp + u_) * DR + ch0 + c4; \
            qr[S_][u_] = *(const u32x2*)(P.r + o_); qx[S_][u_] = *(const u32x2*)(P.x + o_); qk[S_][u_] = *(const u32x2*)(P.km + o_); qa[S_][u_] = *(const u32x2*)(P.kk + o_); qb[S_][u_] = *(const u32x2*)(P.b + o_); } \
        qv[S_] = *(const unsigned*)(P.v + (m0 + (size_t)(c) * RC + s) * DR + ch0 + 16 * rg + 2 * c8); } while (0)
#define RW_WRITE(buf, S_) do { LAS float* B_ = L + (buf) * RB_FLOATS; float c1_ = 0.f, c2_ = 0.f, br0_ = 0.f, kr0_ = 0.f, d1_ = 0.f, d2_ = 0.f, br1_ = 0.f, kr1_ = 0.f; \
        f32x4 o_[9]; \
        _Pragma("unroll") for (int e_ = 0; e_ < 4; ++e_) { \
            const unsigned wr0u = qr[S_][0][e_ >> 1], wx0u = qx[S_][0][e_ >> 1], wk0u = qk[S_][0][e_ >> 1], wa0u = qa[S_][0][e_ >> 1], wb0u = qb[S_][0][e_ >> 1]; \
            const unsigned wr1u = qr[S_][1][e_ >> 1], wx1u = qx[S_][1][e_ >> 1], wk1u = qk[S_][1][e_ >> 1], wa1u = qa[S_][1][e_ >> 1], wb1u = qb[S_][1][e_ >> 1]; \
            const float r0 = (e_ & 1) ? h_hi(wr0u) : h_lo(wr0u), w0 = 1.f - ((e_ & 1) ? h_hi(wx0u) : h_lo(wx0u)), k0 = (e_ & 1) ? h_hi(wk0u) : h_lo(wk0u), a0 = (e_ & 1) ? h_hi(wa0u) : h_lo(wa0u), b0 = (e_ & 1) ? h_hi(wb0u) : h_lo(wb0u); \
            const float r1 = (e_ & 1) ? h_hi(wr1u) : h_lo(wr1u), w1 = 1.f - ((e_ & 1) ? h_hi(wx1u) : h_lo(wx1u)), k1 = (e_ & 1) ? h_hi(wk1u) : h_lo(wk1u), a1 = (e_ & 1) ? h_hi(wa1u) : h_lo(wa1u), b1 = (e_ & 1) ? h_hi(wb1u) : h_lo(wb1u); \
            const float wr1 = w1 * r1; \
            o_[0][e_] = a0; o_[1][e_] = w0 * r0; o_[2][e_] = w0 * a1; o_[3][e_] = w0 * wr1; o_[4][e_] = w0 * w1; o_[5][e_] = k0 * w1; o_[6][e_] = b0 * w1; o_[7][e_] = k1; o_[8][e_] = b1; \
            c1_ += b0 * a1; c2_ += k0 * a1; br0_ += b0 * r0; kr0_ += k0 * r0; d1_ += b0 * wr1; d2_ += k0 * wr1; br1_ += b1 * r1; kr1_ += k1 * r1; } \
        _Pragma("unroll") for (int j_ = 0; j_ < 9; ++j_) *(LAS f32x4*)(B_ + RB_VEC + (pp * 9 + j_) * 64 + c4) = o_[j_]; \
        c1_ = row16_sum(c1_); c2_ = row16_sum(c2_); br0_ = row16_sum(br0_); kr0_ = row16_sum(kr0_); d1_ = row16_sum(d1_); d2_ = row16_sum(d2_); br1_ = row16_sum(br1_); kr1_ = row16_sum(kr1_); \
        if ((ht & 15) == 0) { *(LAS f32x4*)(B_ + RB_SCL + pp * 12) = (f32x4){c1_, c2_, br0_ * 0.0625f, kr0_ * 0.0625f}; *(LAS f32x4*)(B_ + RB_SCL + pp * 12 + 4) = (f32x4){d1_ * 0.0625f, d2_ * 0.0625f, br1_ * 0.0625f, kr1_ * 0.0625f}; } \
        *(LAS f32x2*)(B_ + RB_V + s * 16 + 2 * c8) = (f32x2){h_lo(qv[S_]), h_hi(qv[S_])}; } while (0)
#define RW_STOREY(buf, c) do { const LAS float* B_ = L + (buf) * RB_FLOATS; float y_[2]; \
        _Pragma("unroll") for (int q_ = 0; q_ < 2; ++q_) { const LAS f32x4* yp_ = (const LAS f32x4*)(B_ + RB_Y + (s * 16 + 2 * c8 + q_) * 16); \
            const f32x4 a_ = yp_[0], b_ = yp_[1], c_ = yp_[2], d_ = yp_[3]; \
            y_[q_] = ((a_.x + a_.y) + (a_.z + a_.w)) + ((b_.x + b_.y) + (b_.z + b_.w)) + (((c_.x + c_.y) + (c_.z + c_.w)) + ((d_.x + d_.y) + (d_.z + d_.w))); } \
        *(unsigned*)(MIX + (m0 + (size_t)(c) * RC + s) * D + ch0 + 16 * rg + 2 * c8) = pk2(y_[0], y_[1]); } while (0)
        RW_LOAD(0, 0); RW_WRITE(0, 0); RW_LOAD(1, 1); RW_LOAD(2, 0);
        __syncthreads();
        for (int c = 0; c < NCH; c += 2) {
            if (c + 1 < NCH) RW_WRITE(1, 1);
            if (c + 3 < NCH) RW_LOAD(c + 3, 1);
            if (c > 0) RW_STOREY(1, c - 1);
            __syncthreads();
            if (c + 2 < NCH) RW_WRITE(0, 0);
            if (c + 4 < NCH) RW_LOAD(c + 4, 0);
            RW_STOREY(0, c);
            __syncthreads();
        }
        RW_STOREY((NCH - 1) & 1, NCH - 1);
#undef RW_LOAD
#undef RW_WRITE
#undef RW_STOREY
    } else {
        const int g4 = F.lane >> 4, l = F.lane & 15, vrow = F.wave * 4 + g4;
        f32x2 Sa = (f32x2){0.f, 0.f}, Sb = (f32x2){0.f, 0.f};
        struct PairV { f32x4 v[9]; f32x4 sa, sb; float vv0, vv1; };
#define SC_LD(d, p_) do { _Pragma("unroll") for (int j_ = 0; j_ < 9; ++j_) d.v[j_] = *(const LAS f32x4*)(B + RB_VEC + ((p_) * 9 + j_) * 64 + 4 * l); \
        d.sa = *(const LAS f32x4*)(B + RB_SCL + (p_) * 12); d.sb = *(const LAS f32x4*)(B + RB_SCL + (p_) * 12 + 4); d.vv0 = B[RB_V + (2 * (p_)) * 16 + vrow]; d.vv1 = B[RB_V + (2 * (p_) + 1) * 16 + vrow]; } while (0)
#define LO2(q_) ((f32x2){(q_).x, (q_).y})
#define HI2(q_) ((f32x2){(q_).z, (q_).w})
#define SC_PAIR(d, p_) do { \
        const f32x2 t1 = Sa * LO2(d.v[0]) + Sb * HI2(d.v[0]), t2 = Sa * LO2(d.v[1]) + Sb * HI2(d.v[1]), t3 = Sa * LO2(d.v[2]) + Sb * HI2(d.v[2]), t4 = Sa * LO2(d.v[3]) + Sb * HI2(d.v[3]); \
        const float p1 = row16_sum(t1.x + t1.y), r3 = row16_sum(t3.x + t3.y); \
        const float p1n = r3 - p1 * d.sa.x + d.vv0 * d.sa.y; \
        Y[(2 * (p_)) * 256 + vrow * 16 + l] = (t2.x + t2.y) + (d.vv0 * d.sa.w - p1 * d.sa.z); \
        Y[(2 * (p_) + 1) * 256 + vrow * 16 + l] = (t4.x + t4.y) + ((d.vv0 * d.sb.y - p1 * d.sb.x) + (d.vv1 * d.sb.w - p1n * d.sb.z)); \
        const f32x2 ea = (LO2(d.v[5]) * d.vv0 - LO2(d.v[6]) * p1) + (LO2(d.v[7]) * d.vv1 - LO2(d.v[8]) * p1n), eb = (HI2(d.v[5]) * d.vv0 - HI2(d.v[6]) * p1) + (HI2(d.v[7]) * d.vv1 - HI2(d.v[8]) * p1n); \
        Sa = Sa * LO2(d.v[4]) + ea; Sb = Sb * HI2(d.v[4]) + eb; } while (0)
        __syncthreads();
        for (int c = 0; c < NCH; ++c) {
            const LAS float* B = L + (c & 1) * RB_FLOATS; LAS float* Y = L + (c & 1) * RB_FLOATS + RB_Y;
            PairV a0, a1;
            SC_LD(a0, 0);
#pragma unroll
            for (int p = 0; p < RC / 2; p += 2) {
                SC_LD(a1, p + 1);
                SC_PAIR(a0, p);
                if (p + 2 < RC / 2) SC_LD(a0, p + 2);
                SC_PAIR(a1, p + 1);
            }
            __syncthreads();
        }
#undef SC_LD
#undef SC_PAIR
#undef LO2
#undef HI2
    }
}

constexpr size_t WS_KT = 896 * MiB, WS_VT = 960 * MiB;
constexpr int TR_P = 136;
static_assert(2 * 256 * TR_P * 2 <= LDS_BYTES, "transpose LDS");
__device__ __forceinline__ float ret_lg2gamma(int h) { return log2f(1.0f - exp2f(-5.0f - (float)h)); }
__device__ __forceinline__ void ret_transpose_unit(Frame& F, int unit) {
    const int n = unit & 127, bh = unit >> 7, b = bh >> 2, h = bh & 3;
    const bf16* HB = (const bf16*)(F.ws + WS_HB); bf16* KT = (bf16*)(F.ws + WS_KT) + (size_t)unit * 32768; bf16* VT = (bf16*)(F.ws + WS_VT) + (size_t)unit * 32768;
    LAS bf16* TK = (LAS bf16*)F.lds; LAS bf16* TV = TK + 256 * TR_P;
    const int w = F.wave, cl = F.lane & 15, dq = F.lane >> 4, c = 16 * w + cl;
    const float dk = exp2f((float)(127 - c) * ret_lg2gamma(h));
    const size_t r0 = (size_t)b * T + (size_t)n * 128;
    u32x4 kreg[8], vreg[8];
#pragma unroll
    for (int i = 0; i < 8; ++i) { kreg[i] = *(const u32x4*)(HB + (r0 + c) * NB + 1024 + h * 256 + (4 * i + dq) * 8); vreg[i] = *(const u32x4*)(HB + (r0 + c) * NB + 2048 + h * 256 + (4 * i + dq) * 8); }
#pragma unroll
    for (int i = 0; i < 8; ++i) { const int d0 = (4 * i + dq) * 8;
#pragma unroll
        for (int e = 0; e < 4; ++e) { TK[(d0 + 2 * e) * TR_P + c] = (bf16)f2bf(bf_lo(kreg[i][e]) * dk); TK[(d0 + 2 * e + 1) * TR_P + c] = (bf16)f2bf(bf_hi(kreg[i][e]) * dk);
            TV[(d0 + 2 * e) * TR_P + c] = (bf16)(vreg[i][e] & 0xffffu); TV[(d0 + 2 * e + 1) * TR_P + c] = (bf16)(vreg[i][e] >> 16); } }
    __syncthreads();
#pragma unroll
    for (int i = 0; i < 8; ++i) { const int idx = i * 512 + F.tid, d = idx >> 4, chk = idx & 15;
        *(u32x4*)(KT + d * 128 + 8 * chk) = *(const LAS u32x4*)(TK + d * TR_P + 8 * chk); *(u32x4*)(VT + d * 128 + 8 * chk) = *(const LAS u32x4*)(TV + d * TR_P + 8 * chk); }
    __syncthreads();
}
constexpr int KT_P = 136, RT_P = 264;
constexpr int RS_KT = 0, RS_VT = 256 * KT_P * 2, RS_RT = RS_VT + 32 * KT_P * 2, RS_END = RS_RT + 32 * RT_P * 2;
static_assert(RS_END <= LDS_BYTES, "retention scan LDS");
__device__ __forceinline__ void ret_scan_unit(Frame& F, int ru) {
    const int bh = ru >> 3, es = ru & 7, b = bh >> 2, h = bh & 3, e0 = 32 * es;
    const bf16* HB = (const bf16*)(F.ws + WS_HB); bf16* MIX = (bf16*)(F.ws + WS_MIX);
    LAS bf16* KT = (LAS bf16*)(F.lds + RS_KT); LAS bf16* VT = (LAS bf16*)(F.lds + RS_VT); LAS bf16* RT = (LAS bf16*)(F.lds + RS_RT);
    const float lg = ret_lg2gamma(h); const float g128 = exp2f(128.f * lg);
    const int w = F.wave, lane = F.lane, cl = lane & 15, dq = lane >> 4;
    const bf16* KTg = (const bf16*)(F.ws + WS_KT) + (size_t)bh * 128 * 32768; const bf16* VTg = (const bf16*)(F.ws + WS_VT) + (size_t)bh * 128 * 32768;
    for (int i = F.tid; i < 32 * RT_P / 2; i += 512) ((LAS unsigned*)RT)[i] = 0u;
    pg8::f32x4 acc[2][2];
#pragma unroll
    for (int i = 0; i < 2; ++i)
#pragma unroll
        for (int j = 0; j < 2; ++j) acc[i][j] = (pg8::f32x4){0.f, 0.f, 0.f, 0.f};
    u32x4 kreg[8], vreg, qreg[8];
    const size_t mb = (size_t)b * T;
#define RS_LOAD(n) do { const size_t r0_ = mb + (size_t)(n) * 128; \
        _Pragma("unroll") for (int i_ = 0; i_ < 8; ++i_) { const int idx_ = i_ * 512 + F.tid; kreg[i_] = *(const u32x4*)(KTg + (size_t)(n) * 32768 + (idx_ >> 4) * 128 + 8 * (idx_ & 15)); } \
        vreg = *(const u32x4*)(VTg + (size_t)(n) * 32768 + (e0 + (F.tid >> 4)) * 128 + 8 * (F.tid & 15)); \
        _Pragma("unroll") for (int k_ = 0; k_ < 8; ++k_) qreg[k_] = *(const u32x4*)(HB + (r0_ + 16 * w + cl) * NB + h * 256 + 32 * k_ + dq * 8); } while (0)
    RS_LOAD(0);
    for (int n = 0; n < T / 128; ++n) {
#pragma unroll
        for (int i = 0; i < 8; ++i) { const int idx = i * 512 + F.tid; *(LAS u32x4*)(KT + (idx >> 4) * KT_P + 8 * (idx & 15)) = kreg[i]; }
        *(LAS u32x4*)(VT + (F.tid >> 4) * KT_P + 8 * (F.tid & 15)) = vreg;
        __syncthreads();
        bf16x8 qcur[8];
#pragma unroll
        for (int k_ = 0; k_ < 8; ++k_) qcur[k_] = __builtin_bit_cast(bf16x8, qreg[k_]);
        if (n + 1 < T / 128) RS_LOAD(n + 1);
        { pg8::f32x4 cx[2] = {(pg8::f32x4){0.f, 0.f, 0.f, 0.f}, (pg8::f32x4){0.f, 0.f, 0.f, 0.f}};
#pragma unroll
          for (int ks = 0; ks < 8; ++ks)
#pragma unroll
              for (int et = 0; et < 2; ++et) { const bf16x8 Bf = *(const LAS bf16x8*)(RT + (16 * et + cl) * RT_P + 32 * ks + dq * 8);
                  cx[et] = __builtin_amdgcn_mfma_f32_16x16x32_bf16(qcur[ks], Bf, cx[et], 0, 0, 0); }
#pragma unroll
          for (int r = 0; r < 4; ++r) { const int c = 16 * w + dq * 4 + r; const float qd = exp2f((float)(c + 1) * lg);
#pragma unroll
              for (int et = 0; et < 2; ++et) MIX[(mb + (size_t)n * 128 + c) * D + DR + h * 256 + e0 + 16 * et + cl] = (bf16)f2bf(cx[et][r] * qd); } }
#pragma unroll
        for (int dt = 0; dt < 2; ++dt)
#pragma unroll
            for (int et = 0; et < 2; ++et) acc[dt][et] = acc[dt][et] * g128;
#pragma unroll
        for (int kc = 0; kc < 4; ++kc) { bf16x8 Af[2], Bf[2];
#pragma unroll
            for (int dt = 0; dt < 2; ++dt) Af[dt] = *(const LAS bf16x8*)(KT + (32 * w + 16 * dt + cl) * KT_P + 32 * kc + dq * 8);
#pragma unroll
            for (int et = 0; et < 2; ++et) Bf[et] = *(const LAS bf16x8*)(VT + (16 * et + cl) * KT_P + 32 * kc + dq * 8);
#pragma unroll
            for (int dt = 0; dt < 2; ++dt)
#pragma unroll
                for (int et = 0; et < 2; ++et) acc[dt][et] = __builtin_amdgcn_mfma_f32_16x16x32_bf16(Af[dt], Bf[et], acc[dt][et], 0, 0, 0); }
        __syncthreads();
#pragma unroll
        for (int dt = 0; dt < 2; ++dt)
#pragma unroll
            for (int et = 0; et < 2; ++et) { u32x2 p; p.x = pk2(acc[dt][et][0], acc[dt][et][1]); p.y = pk2(acc[dt][et][2], acc[dt][et][3]);
                *(LAS u32x2*)(RT + (16 * et + cl) * RT_P + 32 * w + 16 * dt + dq * 4) = p; }
    }
#undef RS_LOAD
    __syncthreads();
}
constexpr int KS_P = 264, VT_P = 136, PW_P = 136;
constexpr int RI_KS = 0, RI_VT = 128 * KS_P * 2, RI_END = RI_VT + 256 * VT_P * 2;
static_assert(RI_END <= LDS_BYTES && 8 * 16 * PW_P * 2 <= RI_VT, "retention intra LDS");
__device__ __forceinline__ void ret_intra_unit(Frame& F, const Args& a, int unit) {
    const int n = unit & 127, bh = unit >> 7, b = bh >> 2, h = bh & 3;
    const bf16* HB = (const bf16*)(F.ws + WS_HB); bf16* MIX = (bf16*)(F.ws + WS_MIX);
    LAS bf16* KS = (LAS bf16*)(F.lds + RI_KS); LAS bf16* VT = (LAS bf16*)(F.lds + RI_VT);
    const int w = F.wave, lane = F.lane, cl = lane & 15, dq = lane >> 4;
    const float lg = ret_lg2gamma(h);
    const size_t r0 = (size_t)b * T + (size_t)n * 128;
#pragma unroll
    for (int i = 0; i < 8; ++i) { const int idx = i * 512 + F.tid, c = idx >> 5, chk = idx & 31;
        *(LAS u32x4*)(KS + c * KS_P + 8 * chk) = *(const u32x4*)(HB + (r0 + c) * NB + 1024 + h * 256 + 8 * chk); }
    { const bf16* VTg = (const bf16*)(F.ws + WS_VT) + (size_t)unit * 32768;
#pragma unroll
      for (int i = 0; i < 8; ++i) { const int idx = i * 512 + F.tid, e = idx >> 4, chk = idx & 15; *(LAS u32x4*)(VT + e * VT_P + 8 * chk) = *(const u32x4*)(VTg + e * 128 + 8 * chk); } }
    bf16x8 qf[8];
#pragma unroll
    for (int ks = 0; ks < 8; ++ks) qf[ks] = __builtin_bit_cast(bf16x8, *(const u32x4*)(HB + (r0 + 16 * w + cl) * NB + h * 256 + 32 * ks + dq * 8));
    __syncthreads();
    pg8::f32x4 s[8];
#pragma unroll
    for (int mt = 0; mt < 8; ++mt) { s[mt] = (pg8::f32x4){0.f, 0.f, 0.f, 0.f};
        if (mt <= w) {
#pragma unroll
            for (int ks = 0; ks < 8; ++ks) { const bf16x8 Bf = *(const LAS bf16x8*)(KS + (16 * mt + cl) * KS_P + 32 * ks + dq * 8);
                s[mt] = __builtin_amdgcn_mfma_f32_16x16x32_bf16(qf[ks], Bf, s[mt], 0, 0, 0); } } }
    __syncthreads();
    LAS bf16* PW = (LAS bf16*)(F.lds) + w * 16 * PW_P;
#pragma unroll
    for (int mt = 0; mt < 8; ++mt)
#pragma unroll
        for (int r = 0; r < 4; ++r) { const int cc = 16 * w + dq * 4 + r, mm = 16 * mt + cl; const float dm = (mm <= cc) ? exp2f((float)(cc - mm) * lg) : 0.f;
            PW[(dq * 4 + r) * PW_P + mm] = (bf16)f2bf(s[mt][r] * dm); }
    LDS_WAIT(); asm volatile("" ::: "memory");
    pg8::f32x4 o[16];
#pragma unroll
    for (int et = 0; et < 16; ++et) o[et] = (pg8::f32x4){0.f, 0.f, 0.f, 0.f};
#pragma unroll
    for (int kc = 0; kc < 4; ++kc) if (kc <= (w >> 1)) { const bf16x8 Af = *(const LAS bf16x8*)(PW + cl * PW_P + 32 * kc + dq * 8);
#pragma unroll
        for (int et = 0; et < 16; ++et) { const bf16x8 Bf = *(const LAS bf16x8*)(VT + (16 * et + cl) * VT_P + 32 * kc + dq * 8);
            o[et] = __builtin_amdgcn_mfma_f32_16x16x32_bf16(Af, Bf, o[et], 0, 0, 0); } }
    const float* gnw = a.in[13] + h * 256;
#pragma unroll
    for (int r = 0; r < 4; ++r) { const size_t row = r0 + 16 * w + dq * 4 + r; bf16* mp = MIX + row * D + DR + h * 256 + cl; const bf16* gp = HB + row * NB + 3072 + h * 256 + cl;
        float sum = 0.f;
#pragma unroll
        for (int et = 0; et < 16; ++et) { o[et][r] += bf1(mp[16 * et]); sum += o[et][r]; }
        const float mean = row16_sum(sum) * (1.f / 256.f); float q = 0.f;
#pragma unroll
        for (int et = 0; et < 16; ++et) { const float d = o[et][r] - mean; q += d * d; }
        const float rstd = 1.f / sqrtf(row16_sum(q) * (1.f / 256.f) + RET_GN_EPS);
#pragma unroll
        for (int et = 0; et < 16; ++et) { const float g = bf1(gp[16 * et]); const float y = (o[et][r] - mean) * rstd * gnw[16 * et + cl] * (g * sigmoidf_(g)); mp[16 * et] = (bf16)f2bf(y); } }
    __syncthreads();
}
__device__ __forceinline__ void rwkv_finalize(Frame& F, const Args& a) {
    const Prep P = prep_ptrs(F); bf16* MIX = (bf16*)(F.ws + WS_MIX); const f16b* G = (const f16b*)(F.ws + WS_G);
    const int c0 = 16 * F.lane, hd = F.lane >> 2;
    float gw_[16], gb_[16];
#pragma unroll
    for (int j = 0; j < 4; ++j) { const f32x4 x = *(const f32x4*)(a.in[11] + c0 + 4 * j), y = *(const f32x4*)(a.in[12] + c0 + 4 * j);
        gw_[4 * j] = x.x; gw_[4 * j + 1] = x.y; gw_[4 * j + 2] = x.z; gw_[4 * j + 3] = x.w; gb_[4 * j] = y.x; gb_[4 * j + 1] = y.y; gb_[4 * j + 2] = y.z; gb_[4 * j + 3] = y.w; }
    for (int m = F.gw; m < M; m += F.NGW) {
        u32x4 yv[2], vv[2], gv[2];
        yv[0] = __builtin_nontemporal_load((const u32x4*)(MIX + (size_t)m * D + c0)); yv[1] = __builtin_nontemporal_load((const u32x4*)(MIX + (size_t)m * D + c0 + 8));
        vv[0] = __builtin_nontemporal_load((const u32x4*)(P.v + (size_t)m * DR + c0)); vv[1] = __builtin_nontemporal_load((const u32x4*)(P.v + (size_t)m * DR + c0 + 8));
        gv[0] = __builtin_nontemporal_load((const u32x4*)(G + (size_t)m * DR + c0)); gv[1] = __builtin_nontemporal_load((const u32x4*)(G + (size_t)m * DR + c0 + 8));
        const float bon = P.bon[(size_t)m * 16 + hd];
        float y[16]; float s = 0.f;
#pragma unroll
        for (int j = 0; j < 8; ++j) { y[2 * j] = bf_lo(yv[j >> 2][j & 3]); y[2 * j + 1] = bf_hi(yv[j >> 2][j & 3]); s += y[2 * j] + y[2 * j + 1]; }
        s += __shfl_xor(s, 1); s += __shfl_xor(s, 2); const float mean = s * (1.f / 64.f); float q = 0.f;
#pragma unroll
        for (int j = 0; j < 16; ++j) { y[j] -= mean; q += y[j] * y[j]; }
        q += __shfl_xor(q, 1); q += __shfl_xor(q, 2); const float rstd = 1.f / sqrtf(q * (1.f / 64.f) + RWKV_GN_EPS);
        u32x4 ov[2];
#pragma unroll
        for (int j = 0; j < 8; ++j) { const unsigned vw = vv[j >> 2][j & 3], gw2 = gv[j >> 2][j & 3];
            const float o0 = (y[2 * j] * rstd * gw_[2 * j] + gb_[2 * j] + bon * h_lo(vw)) * h_lo(gw2);
            const float o1 = (y[2 * j + 1] * rstd * gw_[2 * j + 1] + gb_[2 * j + 1] + bon * h_hi(vw)) * h_hi(gw2);
            ov[j >> 2][j & 3] = pk2(o0, o1); }
        *(u32x4*)(MIX + (size_t)m * D + c0) = ov[0]; *(u32x4*)(MIX + (size_t)m * D + c0 + 8) = ov[1];
    }
}

constexpr int N_PHASES = 12;
__global__ void __launch_bounds__(NWAVES * 64, 2) fwd_kernel(Args args) {
    extern __shared__ __attribute__((aligned(16))) unsigned char lds_raw[];
    Frame F;
    F.lds = (LAS unsigned char*)lds_raw; F.ws = args.ws; F.out = args.out;
    F.tid = threadIdx.x; F.lane = F.tid & 63; F.wave = __builtin_amdgcn_readfirstlane(F.tid >> 6);
    F.G = gridDim.x; F.gw = blockIdx.x * NWAVES + F.wave; F.NGW = F.G * NWAVES;
    const int lo = args.ph_lo, hi = args.ph_hi;
#define IN(k) (lo <= (k) && (k) < hi)
    unsigned nbar = 0u; unsigned* gctr = (unsigned*)(args.ws + WS_CTL) + 128;
    volatile LAS unsigned* xst = (volatile LAS unsigned*)(F.lds + LDS_BYTES - 64);
    if (F.tid < 16) xst[F.tid] = 0u;
    __syncthreads();
    XcdBarrier xbar = xcd_barrier_post((unsigned*)(args.ws + WS_CTL) + 2048, xst);
#define SEAM(k) do { if (IN(k) && IN((k) + 1)) { if (args.coop == 1) { xcd_barrier(xbar); } else if (args.coop == 3) { nbar += (unsigned)F.G; sub_barrier(gctr, nbar); } else if (args.coop == 2) cg::this_grid().sync(); } } while (0)
    typedef pg8::bf16_t b16;
    if (IN(0)) { p0_prologue(F, args); } SEAM(0);
    if (IN(1)) {
        pg8::Gemm g{(const b16*)(F.ws + WS_XB), (const b16*)(F.ws + WS_WIN), M, N1A, D}; pg8::StaticOrder S; S.init(M, N1A, F.G, (int)blockIdx.x);
        pg8::EpiH16<0> E{(b16*)(F.ws + WS_HA), (b16*)(F.ws + WS_HB), (b16*)(F.ws + WS_HB), NA, NB, NB, NA, 1 << 30};
        pg8::gemm_phase<pg8::EpiH16<0>, pg8::StaticOrder, true, true>(F.lds, g, S, E);
    } SEAM(1);
    if (IN(2)) { p2a_prep(F, args); } SEAM(2);
    if (IN(3)) {
        pg8::Gemm g{(const b16*)((unsigned char*)F.out + OUT_AP), (const b16*)(F.ws + WS_WL), M, 3072, args.klora}; pg8::StaticOrder S; S.init(M, 3072, F.G, (int)blockIdx.x);
        pg8::EpiH16<2> E{(b16*)(F.ws + WS_LRW), (b16*)(F.ws + WS_LRA), (b16*)(F.ws + WS_G), DR, DR, DR, 1024, 2048};
        pg8::gemm_phase<pg8::EpiH16<2>, pg8::StaticOrder, true, true>(F.lds, g, S, E);
    } SEAM(3);
    if (IN(4)) { p2c_rwkv_prep(F, args); } SEAM(4);
    if (IN(5)) {
        if (blockIdx.x < 128) {
            const int i_ = (int)blockIdx.x, x_ = i_ & 7, j_ = i_ >> 3; rwkv_scan_unit(F, ((((j_ >> 2) << 3) + x_) << 2) | (j_ & 3)); }
        else {
            const int bb = (int)blockIdx.x - 128; unsigned* ctr = (unsigned*)(F.ws + WS_CTL) + 64;
            {
                pg8::Gemm g{(const b16*)(F.ws + WS_XB), (const b16*)(F.ws + WS_WIN) + (size_t)N1A * D, M, 6400 - N1A, D}; pg8::StaticOrder S; S.init(M, 6400 - N1A, 128, bb);
                pg8::EpiH16<0> E{(b16*)(F.ws + WS_HB) + (N1A - NA), (b16*)(F.ws + WS_HB), (b16*)(F.ws + WS_HB), NB, NB, NB, 1 << 30, 1 << 30};
                pg8::gemm_phase<pg8::EpiH16<0>, pg8::StaticOrder, true, true>(F.lds, g, S, E);
            }
            sub_barrier(ctr, 128u);
            ret_rotary(F, bb * NWAVES + F.wave, 128 * NWAVES);
            sub_barrier(ctr, 256u);
            for (int u = bb; u < 1024; u += 128) ret_transpose_unit(F, u);
            sub_barrier(ctr, 384u);
            if (bb < 64) ret_scan_unit(F, ((bb & 7) << 3) | (bb >> 3));
            else {
                p0_late_weights(F, args, (bb - 64) * NWAVES + F.wave, 64 * NWAVES);
                __syncthreads();
                pg8::Gemm g{(const b16*)(F.ws + WS_XB), (const b16*)(F.ws + WS_WIN) + (size_t)6400 * D, M, 1024, D}; pg8::StaticOrder S; S.init(M, 1024, 64, bb - 64);
                pg8::EpiH16<0> E{(b16*)(F.ws + WS_HB) + 3072, (b16*)(F.ws + WS_HB), (b16*)(F.ws + WS_HB), NB, NB, NB, 1 << 30, 1 << 30};
                pg8::gemm_phase<pg8::EpiH16<0>, pg8::StaticOrder, true, true>(F.lds, g, S, E);
            }
            sub_barrier(ctr, 512u);
        }
    }
    if (IN(5)) { if (blockIdx.x >= 128) { for (int u = (int)blockIdx.x - 128; u < 1024; u += 128) ret_intra_unit(F, args, u); } } SEAM(5);
    if (IN(6)) { rwkv_finalize(F, args); } SEAM(6);
    if (IN(7)) {
        pg8::Gemm g{(const b16*)(F.ws + WS_MIX), (const b16*)(F.ws + WS_WO), M, D, D}; pg8::StaticOrder S; S.init(M, D, F.G, (int)blockIdx.x);
        pg8::EpiH16<0> E{(b16*)(F.ws + WS_HB), (b16*)(F.ws + WS_HB), (b16*)(F.ws + WS_HB), D, D, D, 1 << 30, 1 << 30};
        pg8::gemm_phase<pg8::EpiH16<0>, pg8::StaticOrder, true, true>(F.lds, g, S, E);
    } SEAM(7);
    if (IN(8)) { ln_pass<false>(F, args.in[0], (const bf16*)(F.ws + WS_HB), nullptr, (bf16*)(F.ws + WS_X1B), args.in[15], args.in[16]); } SEAM(8);
    if (IN(9)) {
        pg8::Gemm g{(const b16*)(F.ws + WS_X1B), (const b16*)(F.ws + WS_WUP), M, DFF, D}; pg8::StaticOrder S; S.init(M, DFF, F.G, (int)blockIdx.x);
        pg8::EpiH16<1> E{(b16*)(F.ws + WS_U), (b16*)(F.ws + WS_U), (b16*)(F.ws + WS_U), DFF, DFF, DFF, 1 << 30, 1 << 30};
        pg8::gemm_phase<pg8::EpiH16<1>, pg8::StaticOrder, true, true>(F.lds, g, S, E);
    } SEAM(9);
    if (IN(10)) {
        pg8::Gemm g{(const b16*)(F.ws + WS_U), (const b16*)(F.ws + WS_WDN), M, D, DFF}; pg8::StaticOrder S; S.init(M, D, F.G, (int)blockIdx.x);
        pg8::EpiH16<0> E{(b16*)(F.ws + WS_KT), (b16*)(F.ws + WS_KT), (b16*)(F.ws + WS_KT), D, D, D, 1 << 30, 1 << 30};
        pg8::gemm_phase<pg8::EpiH16<0>, pg8::StaticOrder, true, true>(F.lds, g, S, E);
    } SEAM(10);
    if (IN(11)) { ln_pass<true>(F, (const bf16*)(F.ws + WS_X1B), (const bf16*)(F.ws + WS_KT), F.out, nullptr, args.in[19], args.in[20]); }
#undef IN
#undef SEAM
}

extern "C" void kernel_launch(void* const* d_in, const int* in_sizes, int n_in, void* d_out, int out_size, void* d_ws, size_t ws_size, hipStream_t stream) {
    static int grid = 0;
    if (grid == 0) {
        if (n_in != 21 || in_sizes[0] != M * D || out_size != M * D || ws_size < WS_END) { fprintf(stderr, "kernel_launch: unexpected shapes: n_in %d in0 %d out %d ws %zu\n", n_in, n_in > 0 ? in_sizes[0] : -1, out_size, ws_size); grid = -1; return; }
        int dev = 0, cus = 0;
        if (hipGetDevice(&dev) != hipSuccess || hipDeviceGetAttribute(&cus, hipDeviceAttributeMultiprocessorCount, dev) != hipSuccess) { grid = -1; return; }
        if (hipFuncSetAttribute((const void*)fwd_kernel, hipFuncAttributeMaxDynamicSharedMemorySize, LDS_BYTES) != hipSuccess) { fprintf(stderr, "kernel_launch: hipFuncSetAttribute failed\n"); grid = -1; return; }
        (void)hipGetLastError();
        if (cus < 256) { fprintf(stderr, "kernel_launch: this kernel splits phase 5 over exactly 256 co-resident workgroups; device has %d CUs\n", cus); grid = -1; return; }
        grid = 256;
    }
    if (grid < 0) return;
    (void)hipMemsetAsync(d_ws, 0, 32768, stream);
    Args a{};
    for (int i = 0; i < 21; ++i) a.in[i] = (const float*)d_in[i];
    a.out = (float*)d_out; a.ws = (unsigned char*)d_ws; a.klora = NLORA;
    a.ph_lo = 0; a.ph_hi = N_PHASES; a.coop = 1;
    void* kargs[] = {&a};
    hipError_t e = hipLaunchCooperativeKernel((const void*)fwd_kernel, dim3(grid), dim3(NWAVES * 64), kargs, LDS_BYTES, stream);
    if (e != hipSuccess) fprintf(stderr, "kernel_launch: cooperative launch failed: %s (grid %d)\n", hipGetErrorString(e), grid);
}
```

```cpp
#include <hip/hip_runtime.h>
#include <hip/hip_cooperative_groups.h>
#include <cstdio>
#include <cstdint>
namespace cg = cooperative_groups;
namespace pg8 {
#define PG8_LAS __attribute__((address_space(3)))
typedef unsigned short bf16_t;
typedef short bf16x8 __attribute__((ext_vector_type(8)));
typedef float f32x4 __attribute__((ext_vector_type(4)));
typedef unsigned u32x4 __attribute__((ext_vector_type(4)));
constexpr int BM = 256, BK = 64, HALF = 128, HTB = HALF * BK * 2  , STAGE_BYTES = 8 * HTB, NXCD = 8, WGM = 8;

__host__ __device__ __forceinline__ int lds_byte(int r, int c) { const int st = (r >> 4) * 2 + (c >> 5), rr = r & 15, cc = c & 31, ob = rr * 64 + cc * 2; return st * 1024 + (ob ^ (((ob >> 9) & 1) << 5)); }
__host__ __device__ __forceinline__ void stage_rc(int b, int& R, int& C) { const int st = b / 1024, sb = b % 1024, swz = sb ^ (((sb >> 9) & 1) << 5); R = (st >> 1) * 16 + swz / 64; C = (st & 1) * 32 + (swz % 64) / 2; }
__host__ __device__ __forceinline__ int perm32(int rho) { const int n = rho >> 4, i = rho & 15; return 8 * (i >> 2) + 4 * n + (i & 3); }

struct Unit { int pm, pn; };
struct Gemm { const bf16_t* A; const bf16_t* Bt; int M, N, K; };

struct StaticOrder {
    int nM, nN, nwg, G, c;
    __host__ __device__ void init(int M, int N, int G_, int c_) { nM = M / BM; nN = N / BM; nwg = nM * nN; G = G_; c = c_; }
    __host__ __device__ bool next(int i, Unit& u) const {
        const long L = (long)i * G + c; if (L >= nwg) return false;
        int wgid = (int)L; { const int q = nwg / NXCD, r = nwg % NXCD, xcd = wgid % NXCD, off = wgid / NXCD; wgid = (xcd < r ? xcd * (q + 1) : r * (q + 1) + (xcd - r) * q) + off; }
        const int nig = WGM * nN, gid = wgid / nig, fm = gid * WGM, gsz = (nM - fm) < WGM ? (nM - fm) : WGM;
        u.pm = fm + ((wgid % nig) % gsz); u.pn = (wgid % nig) / gsz; return true;
    }
    __device__ __forceinline__ void a_ready(const Unit&) const {}
    __device__ __forceinline__ void done(const Unit&) const {}
};

__device__ __forceinline__ unsigned cvt_pk_bf16(float lo, float hi) { unsigned r; asm volatile("v_cvt_pk_bf16_f32 %0, %1, %2" : "=v"(r) : "v"(lo), "v"(hi)); return r; }
typedef _Float16 f16x2_t __attribute__((ext_vector_type(2)));
__device__ __forceinline__ unsigned cvt_pk_f16(float lo, float hi) { f16x2_t v; v.x = (_Float16)lo; v.y = (_Float16)hi; return __builtin_bit_cast(unsigned, v); }
template <int MODE> struct EpiH16 {
    static constexpr bool PERM = true, AFTER_DRAIN = false;
    bf16_t* O0; bf16_t* O1; bf16_t* O2; int ld0, ld1, ld2, split0, split1;
    __device__ __forceinline__ void operator()(const f32x4 (&acc)[2][2][4][2], const Unit& u, int wr, int wc, int fr, int fq) const {
        const int row0 = u.pm * BM + wr * 64 + fr; int colt = u.pn * BM; bf16_t* base = O0; int ldc = ld0;
        if (colt >= split1) { base = O2; ldc = ld2; colt -= split1; } else if (colt >= split0) { base = O1; ldc = ld1; colt -= split0; }
        const int col0 = colt + wc * 32 + 8 * fq;
#pragma unroll
        for (int ai = 0; ai < 2; ++ai)
#pragma unroll
            for (int m = 0; m < 4; ++m) { bf16_t* rowp = base + (size_t)(row0 + ai * HALF + m * 16) * ldc + col0;
#pragma unroll
                for (int bj = 0; bj < 2; ++bj) { f32x4 v0 = acc[ai][bj][m][0], v1 = acc[ai][bj][m][1];
                    if (MODE == 1) {
#pragma unroll
                        for (int e = 0; e < 4; ++e) { float a = fmaxf(v0[e], 0.f), b = fmaxf(v1[e], 0.f); v0[e] = a * a; v1[e] = b * b; } }
                    u32x4 w;
                    if (MODE == 2) { w.x = cvt_pk_f16(v0[0], v0[1]); w.y = cvt_pk_f16(v0[2], v0[3]); w.z = cvt_pk_f16(v1[0], v1[1]); w.w = cvt_pk_f16(v1[2], v1[3]); }
                    else { w.x = cvt_pk_bf16(v0[0], v0[1]); w.y = cvt_pk_bf16(v0[2], v0[3]); w.z = cvt_pk_bf16(v1[0], v1[1]); w.w = cvt_pk_bf16(v1[2], v1[3]); }
                    *(u32x4*)(rowp + bj * HALF) = w; } }
    }
};
struct EpiResid {
    static constexpr bool PERM = false, AFTER_DRAIN = false;
    const float* base; float* out; int ldc; float alpha;
    __device__ __forceinline__ void operator()(const f32x4 (&acc)[2][2][4][2], const Unit& u, int wr, int wc, int fr, int fq) const {
        const int row0 = u.pm * BM + wr * 64 + fr, col0 = u.pn * BM + wc * 32 + 4 * fq;
#pragma unroll
        for (int ai = 0; ai < 2; ++ai)
#pragma unroll
            for (int m = 0; m < 4; ++m) { const size_t off = (size_t)(row0 + ai * HALF + m * 16) * ldc + col0;
#pragma unroll
                for (int bj = 0; bj < 2; ++bj)
#pragma unroll
                    for (int n = 0; n < 2; ++n) { const size_t p = off + bj * HALF + n * 16; const f32x4 b = *(const f32x4*)(base + p); *(f32x4*)(out + p) = b * alpha + acc[ai][bj][m][n]; } }
    }
};
template <class Epi, class Sched, bool ALIGN_EPI = false, bool SP2 = false>
__device__ __forceinline__ void gemm_phase(PG8_LAS unsigned char* lds, const Gemm g, const Sched& S, const Epi& E) {
    const int tid = threadIdx.x, wid = __builtin_amdgcn_readfirstlane(tid >> 6), lane = tid & 63, wr = wid >> 2, wc = wid & 3, fr = lane & 15, fq = lane >> 4;
    const int K = g.K, nt = K / BK;
    unsigned voffA[2], voffB[2];
#pragma unroll
    for (int i = 0; i < 2; ++i) { int R, C; stage_rc(tid * 16 + i * 8192, R, C); const int Rb = Epi::PERM ? ((R & ~31) + perm32(R & 31)) : R;
        voffA[i] = (unsigned)(R * K + C) * 2u; voffB[i] = (unsigned)(Rb * K + C) * 2u; }
    const size_t kstep = (size_t)(BK * 2);
    const size_t hstep = (size_t)HALF * K * 2;
    const size_t tstep = 2 * hstep;
    const unsigned ldsw = (unsigned)wid * 1024u;
    const int aoff = lds_byte(wr * 64 + fr, fq * 8), boff = lds_byte(wc * 32 + fr, fq * 8);
#define PG8_SA(b, h) (((b) * 2 + (h)) * HTB)
#define PG8_SB(b, h) ((4 + (b) * 2 + (h)) * HTB)
#define PG8_STAGE(bufoff, gbase, voff) do { _Pragma("unroll") for (int _i = 0; _i < 2; ++_i) \
        __builtin_amdgcn_global_load_lds((const unsigned*)((const char*)(gbase) + (voff)[_i]), (PG8_LAS unsigned*)(lds + (bufoff) + ldsw + _i * 8192), 16, 0, 0); } while (0)
#define PG8_LDA(dst, b, h) do { _Pragma("unroll") for (int m = 0; m < 4; ++m) _Pragma("unroll") for (int k = 0; k < 2; ++k) dst[m][k] = *(const PG8_LAS bf16x8*)(lds + PG8_SA(b, h) + aoff + m * 2048 + k * 1024); } while (0)
#define PG8_LDB(dst, b, h) do { _Pragma("unroll") for (int n = 0; n < 2; ++n) _Pragma("unroll") for (int k = 0; k < 2; ++k) dst[n][k] = *(const PG8_LAS bf16x8*)(lds + PG8_SB(b, h) + boff + n * 2048 + k * 1024); } while (0)
#define PG8_MMA(ai, bj, At, Bt) do { __builtin_amdgcn_s_setprio(1); _Pragma("unroll") for (int m = 0; m < 4; ++m) _Pragma("unroll") for (int n = 0; n < 2; ++n) _Pragma("unroll") for (int k = 0; k < 2; ++k) \
        acc[ai][bj][m][n] = __builtin_amdgcn_mfma_f32_16x16x32_bf16(Bt[n][k], At[m][k], acc[ai][bj][m][n], 0, 0, 0); __builtin_amdgcn_s_setprio(0); } while (0)
#define PG8_WAIT_V(n) asm volatile("s_waitcnt vmcnt(" #n ")" ::: "memory")
#define PG8_WAIT_L(n) asm volatile("s_waitcnt lgkmcnt(" #n ")" ::: "memory")
#define PG8_BAR __builtin_amdgcn_s_barrier()
#define PG8_SCHED __builtin_amdgcn_sched_barrier(0)
    Unit cur, nxt; int ui = 0;
    if (!S.next(0, cur)) return;
    f32x4 acc[2][2][4][2];
#pragma unroll
    for (int a = 0; a < 2; ++a)
#pragma unroll
        for (int b = 0; b < 2; ++b)
#pragma unroll
            for (int m = 0; m < 4; ++m)
#pragma unroll
                for (int n = 0; n < 2; ++n) acc[a][b][m][n] = (f32x4){0.f, 0.f, 0.f, 0.f};
    bf16x8 At[4][2], B0[2][2], B1[2][2];
    const char* cA = (const char*)g.A + (size_t)cur.pm * tstep; const char* cB = (const char*)g.Bt + (size_t)cur.pn * tstep;
    S.a_ready(cur);
    if constexpr (SP2) {
        PG8_STAGE(PG8_SB(0, 0), cB, voffB); PG8_STAGE(PG8_SB(0, 1), cB + hstep, voffB); PG8_STAGE(PG8_SA(0, 0), cA, voffA); PG8_STAGE(PG8_SA(0, 1), cA + hstep, voffA);
        if (wr == 1) PG8_BAR;
        PG8_WAIT_V(2); PG8_BAR;
        PG8_STAGE(PG8_SB(1, 0), cB + kstep, voffB); PG8_STAGE(PG8_SA(1, 0), cA + kstep, voffA); PG8_STAGE(PG8_SB(1, 1), cB + hstep + kstep, voffB);
        PG8_WAIT_V(6); PG8_BAR;
    } else {
        PG8_STAGE(PG8_SB(0, 0), cB, voffB); PG8_STAGE(PG8_SA(0, 0), cA, voffA); PG8_STAGE(PG8_SB(0, 1), cB + hstep, voffB); PG8_STAGE(PG8_SA(0, 1), cA + hstep, voffA);
        if (wr == 1) PG8_BAR;
        PG8_WAIT_V(4); PG8_BAR;
        PG8_STAGE(PG8_SB(1, 0), cB + kstep, voffB); PG8_STAGE(PG8_SA(1, 0), cA + kstep, voffA); PG8_STAGE(PG8_SB(1, 1), cB + hstep + kstep, voffB);
        PG8_WAIT_V(6); PG8_BAR;
    }
    for (;;) {
        const bool has_next = S.next(ui + 1, nxt);
        const char* nA = has_next ? (const char*)g.A + (size_t)nxt.pm * tstep : cA; const char* nB = has_next ? (const char*)g.Bt + (size_t)nxt.pn * tstep : cB;
        for (int t = 0; t < nt; t += 2) {
            const bool last = (t == nt - 2);
            const char* a1 = cA + (size_t)(t + 1) * kstep;
            const char* a2 = last ? nA : cA + (size_t)(t + 2) * kstep; const char* b2 = last ? nB : cB + (size_t)(t + 2) * kstep;
            const char* a3 = a2 + kstep; const char* b3 = b2 + kstep;
            if (last && has_next) S.a_ready(nxt);
            if constexpr (SP2) {
            PG8_LDB(B0, 0, 0); PG8_LDB(B1, 0, 1); PG8_SCHED; PG8_LDA(At, 0, 0); PG8_STAGE(PG8_SA(1, 1), a1 + hstep, voffA);
            PG8_WAIT_V(8); PG8_WAIT_L(0); PG8_BAR; PG8_MMA(0, 0, At, B0); PG8_MMA(0, 1, At, B1); PG8_BAR; PG8_SCHED;
            PG8_LDA(At, 0, 1); PG8_STAGE(PG8_SB(0, 0), b2, voffB); PG8_STAGE(PG8_SB(0, 1), b2 + hstep, voffB); PG8_STAGE(PG8_SA(0, 0), a2, voffA);
            PG8_WAIT_V(8); PG8_WAIT_L(0); PG8_BAR; PG8_MMA(1, 0, At, B0); PG8_MMA(1, 1, At, B1); PG8_BAR; PG8_SCHED;
            PG8_LDB(B0, 1, 0); PG8_LDB(B1, 1, 1); PG8_SCHED; PG8_LDA(At, 1, 0); PG8_STAGE(PG8_SA(0, 1), a2 + hstep, voffA);
            PG8_WAIT_V(8); PG8_WAIT_L(0); PG8_BAR; PG8_MMA(0, 0, At, B0); PG8_MMA(0, 1, At, B1); PG8_BAR; PG8_SCHED;
            PG8_LDA(At, 1, 1); PG8_STAGE(PG8_SB(1, 0), b3, voffB); PG8_STAGE(PG8_SB(1, 1), b3 + hstep, voffB); PG8_STAGE(PG8_SA(1, 0), a3, voffA);
            PG8_WAIT_V(8); PG8_WAIT_L(0); PG8_BAR; PG8_MMA(1, 0, At, B0); PG8_MMA(1, 1, At, B1); PG8_BAR; PG8_SCHED;
            } else {
            PG8_LDB(B0, 0, 0); PG8_SCHED; PG8_LDA(At, 0, 0); PG8_STAGE(PG8_SA(1, 1), a1 + hstep, voffA);
            PG8_WAIT_L(8); PG8_BAR; PG8_WAIT_L(0); PG8_MMA(0, 0, At, B0); PG8_BAR; PG8_SCHED;
            PG8_LDB(B1, 0, 1); PG8_STAGE(PG8_SB(0, 0), b2, voffB);
            PG8_BAR; PG8_WAIT_L(0); PG8_MMA(0, 1, At, B1); PG8_BAR;
            PG8_LDA(At, 0, 1); PG8_STAGE(PG8_SA(0, 0), a2, voffA);
            PG8_BAR; PG8_WAIT_L(0); PG8_MMA(1, 0, At, B0); PG8_BAR; PG8_SCHED;
            PG8_STAGE(PG8_SB(0, 1), b2 + hstep, voffB);
            PG8_WAIT_V(6); PG8_BAR; PG8_MMA(1, 1, At, B1); PG8_BAR;
            PG8_LDB(B0, 1, 0); PG8_SCHED; PG8_LDA(At, 1, 0); PG8_STAGE(PG8_SA(0, 1), a2 + hstep, voffA);
            PG8_WAIT_L(8); PG8_BAR; PG8_WAIT_L(0); PG8_MMA(0, 0, At, B0); PG8_BAR; PG8_SCHED;
            PG8_LDB(B1, 1, 1); PG8_STAGE(PG8_SB(1, 0), b3, voffB);
            PG8_BAR; PG8_WAIT_L(0); PG8_MMA(0, 1, At, B1); PG8_BAR;
            PG8_LDA(At, 1, 1); PG8_STAGE(PG8_SA(1, 0), a3, voffA);
            PG8_BAR; PG8_WAIT_L(0); PG8_MMA(1, 0, At, B0); PG8_BAR; PG8_SCHED;
            PG8_STAGE(PG8_SB(1, 1), b3 + hstep, voffB);
            PG8_WAIT_V(6); PG8_BAR; PG8_MMA(1, 1, At, B1); PG8_BAR;
            }
        }
        if constexpr (ALIGN_EPI) { if (wr == 0) PG8_BAR; }
        if constexpr (!Epi::AFTER_DRAIN) { E(acc, cur, wr, wc, fr, fq); S.done(cur); }
        if (!has_next) break;
#pragma unroll
        for (int a = 0; a < 2; ++a)
#pragma unroll
            for (int b = 0; b < 2; ++b)
#pragma unroll
                for (int m = 0; m < 4; ++m)
#pragma unroll
                    for (int n = 0; n < 2; ++n) acc[a][b][m][n] = (f32x4){0.f, 0.f, 0.f, 0.f};
        cur = nxt; cA = nA; cB = nB; ++ui;
        if constexpr (ALIGN_EPI) { if (wr == 1) PG8_BAR; }
    }
    PG8_WAIT_V(0);
    if constexpr (!ALIGN_EPI) { if (wr == 0) PG8_BAR; }
    PG8_BAR;
    if constexpr (Epi::AFTER_DRAIN) { E.fused(acc, cur, wr, wc, fr, fq, lds, wid, lane); S.done(cur); }
#undef PG8_SA
#undef PG8_SB
#undef PG8_STAGE
#undef PG8_LDA
#undef PG8_LDB
#undef PG8_MMA
#undef PG8_WAIT_V
#undef PG8_WAIT_L
#undef PG8_BAR
#undef PG8_SCHED
}
}
constexpr int NWAVES = 8;
constexpr int BATCH = 2, T = 16384, M = BATCH * T, D = 2048, NIN = 7424, DFF = 8192;
constexpr int NA = 3328, NB = 4096;
constexpr int DR = 1024;
constexpr int NLORA = 256;
constexpr float LN_EPS = 1e-5f, RWKV_GN_EPS = 64e-5f, RET_GN_EPS = 1e-6f;
constexpr float ALPHA = 1.189207115002721f;
constexpr size_t MiB = 1u << 20;
constexpr size_t WS_CTL = 0, WS_WL = 1 * MiB, WS_BON = 3 * MiB, WS_WIN = 8 * MiB, WS_WO = 38 * MiB, WS_WUP = 46 * MiB, WS_WDN = 78 * MiB;
constexpr size_t WS_XB = 112 * MiB;
constexpr size_t WS_HA = 240 * MiB, WS_MIX = 240 * MiB, WS_HB = 448 * MiB;
constexpr size_t WS_G = 704 * MiB, WS_P5 = 768 * MiB, WS_P6 = 832 * MiB, WS_LRW = 896 * MiB, WS_LRA = 960 * MiB, WS_END = 1024 * MiB;
constexpr size_t WS_U = 240 * MiB, WS_X1B = 768 * MiB;
constexpr size_t OUT_AP = 0;
static_assert(WS_HA + (size_t)M * NA * 2 <= WS_HB && WS_HB + (size_t)M * NB * 2 <= WS_G && WS_U + (size_t)M * DFF * 2 <= WS_X1B, "ws map");
constexpr int N1A = NA + 256;
constexpr int LDS_BYTES = 163840;
#define LAS __attribute__((address_space(3)))
typedef unsigned short bf16;
typedef unsigned short f16b;
typedef float f32x4 __attribute__((ext_vector_type(4)));
typedef float f32x2 __attribute__((ext_vector_type(2)));
typedef unsigned u32x4 __attribute__((ext_vector_type(4)));
typedef unsigned u32x2 __attribute__((ext_vector_type(2)));
typedef short bf16x8 __attribute__((ext_vector_type(8)));
typedef _Float16 h16x2 __attribute__((ext_vector_type(2)));
typedef _Float16 h16x8 __attribute__((ext_vector_type(8)));
#define LDS_WAIT() asm volatile("s_waitcnt lgkmcnt(0)" ::: "memory")

__device__ __forceinline__ unsigned f2bf(float f) { unsigned u = __builtin_bit_cast(unsigned, f); return (u + 0x7fffu + ((u >> 16) & 1u)) >> 16; }
__device__ __forceinline__ unsigned pk2(float lo, float hi) { return f2bf(lo) | (f2bf(hi) << 16); }
__device__ __forceinline__ float bf_lo(unsigned w) { return __builtin_bit_cast(float, w << 16); }
__device__ __forceinline__ float bf_hi(unsigned w) { return __builtin_bit_cast(float, w & 0xffff0000u); }
__device__ __forceinline__ float bf1(bf16 v) { return __builtin_bit_cast(float, (unsigned)v << 16); }
__device__ __forceinline__ unsigned pkh(float lo, float hi) { h16x2 v; v.x = (_Float16)lo; v.y = (_Float16)hi; return __builtin_bit_cast(unsigned, v); }
__device__ __forceinline__ float h_lo(unsigned w) { h16x2 v = __builtin_bit_cast(h16x2, w); return (float)v.x; }
__device__ __forceinline__ float h_hi(unsigned w) { h16x2 v = __builtin_bit_cast(h16x2, w); return (float)v.y; }
__device__ __forceinline__ float wave_sum(float v) {
#pragma unroll
    for (int o = 1; o < 64; o <<= 1) v += __shfl_xor(v, o);
    return v;
}
template <int CTRL> __device__ __forceinline__ float dpp_mov(float x) { return __builtin_bit_cast(float, __builtin_amdgcn_update_dpp(0, __builtin_bit_cast(int, x), CTRL, 0xF, 0xF, true)); }
__device__ __forceinline__ float row16_sum(float x) { x += dpp_mov<0x128>(x); x += dpp_mov<0x124>(x); x += dpp_mov<0x122>(x); x += dpp_mov<0x121>(x); return x; }
__device__ __forceinline__ float fma_s(float a, float b, float c) { float d; asm("v_fma_f32 %0, %1, %2, %3" : "=v"(d) : "v"(a), "v"(b), "v"(c)); return d; }
__device__ __forceinline__ float fnma_s(float a, float b, float c) { float d; asm("v_fma_f32 %0, -%1, %2, %3" : "=v"(d) : "v"(a), "v"(b), "v"(c)); return d; }
__device__ __forceinline__ float mul_s(float a, float b) { float d; asm("v_mul_f32 %0, %1, %2" : "=v"(d) : "v"(a), "v"(b)); return d; }
__device__ __forceinline__ float sigmoidf_(float x) { return 1.f / (1.f + __expf(-x)); }

struct Args { const float* in[21]; float* out; unsigned char* ws; int ph_lo, ph_hi, coop, klora, reps, pad; };
struct Frame {
    LAS unsigned char* lds; unsigned char* ws; float* out;
    int tid, lane, wave, G, gw, NGW;
};

__device__ __forceinline__ void p0_transpose_item(const float* W, int K, int N, bf16* WT, LAS float* scr, int item, int lane, bool remap) {
    const int nblk = N / 32, kb = item / nblk, nb = item % nblk, k0 = 64 * kb, n0 = 32 * nb;
#pragma unroll 32
    for (int i = 0; i < 32; ++i) { const int kk = 2 * i + (lane >> 5); scr[kk * 33 + (lane & 31)] = __builtin_nontemporal_load(W + (size_t)(k0 + kk) * N + n0 + (lane & 31)); }
    LDS_WAIT(); asm volatile("" ::: "memory");
    const int c = lane & 7;
#pragma unroll
    for (int j = 0; j < 4; ++j) { const int n = (lane >> 3) + 8 * j; const LAS float* s = scr + (8 * c) * 33 + n;
        u32x4 o; o.x = pk2(s[0 * 33], s[1 * 33]); o.y = pk2(s[2 * 33], s[3 * 33]); o.z = pk2(s[4 * 33], s[5 * 33]); o.w = pk2(s[6 * 33], s[7 * 33]);
        if (remap) __builtin_nontemporal_store(o, (u32x4*)(WT + (size_t)(n0 + n) * K + k0 + 8 * c)); else *(u32x4*)(WT + (size_t)(n0 + n) * K + k0 + 8 * c) = o; }
    LDS_WAIT(); asm volatile("" ::: "memory");
}
__device__ __forceinline__ void p0_late_weights(Frame& F, const Args& a, int w, int nw) {
    LAS float* scr = (LAS float*)(F.lds + F.wave * 16384);
    const float *w_o = a.in[14], *w_up = a.in[17], *w_dn = a.in[18];
    bf16 *WO = (bf16*)(F.ws + WS_WO), *WUP = (bf16*)(F.ws + WS_WUP), *WDN = (bf16*)(F.ws + WS_WDN);
    constexpr int I_O = (D / 64) * (D / 32), I_UP = (D / 64) * (DFF / 32), I_DN = (DFF / 64) * (D / 32);
    for (int it = w; it < I_O + I_UP + I_DN; it += nw) {
        int r = it;
        if (r < I_O) { p0_transpose_item(w_o, D, D, WO, scr, r, F.lane, true); continue; } r -= I_O;
        if (r < I_UP) { p0_transpose_item(w_up, D, DFF, WUP, scr, r, F.lane, true); continue; } r -= I_UP;
        p0_transpose_item(w_dn, DFF, D, WDN, scr, r, F.lane, true);
    }
}
__device__ __forceinline__ void p0_prologue(Frame& F, const Args& a) {
    LAS float* scr = (LAS float*)(F.lds + F.wave * 16384);
    { const float* w_in = a.in[1]; bf16* WIN = (bf16*)(F.ws + WS_WIN);
      constexpr int I_IN = (D / 64) * (NIN / 32);
      for (int it = F.gw; it < I_IN; it += F.NGW) p0_transpose_item(w_in, D, NIN, WIN, scr, it, F.lane, false); }
    const int gt = F.gw * 64 + F.lane, NGT = F.NGW * 64;
    { bf16* WL = (bf16*)(F.ws + WS_WL); const float *wl = a.in[4], *al = a.in[6], *gl = a.in[7];
      for (int idx = gt; idx < 3072 * NLORA; idx += NGT) { const int n = idx >> 8, k = idx & 255; float v = 0.f;
          if (n < 1024) { if (k < 64) v = wl[k * 1024 + n]; }
          else if (n < 2048) { if (k >= 64 && k < 128) v = al[(k - 64) * 1024 + (n - 1024)]; }
          else { if (k >= 128) v = gl[(k - 128) * 1024 + (n - 2048)]; }
          WL[idx] = (bf16)f2bf(v); } }
    { const float* x = a.in[0]; bf16* XB = (bf16*)(F.ws + WS_XB);
      for (size_t c = gt; c < (size_t)M * D / 8; c += (size_t)4 * NGT) { f32x4 v0[4], v1[4];
#pragma unroll
          for (int q = 0; q < 4; ++q) { const size_t cc = c + (size_t)q * NGT; v0[q] = __builtin_nontemporal_load((const f32x4*)(x + cc * 8)); v1[q] = __builtin_nontemporal_load((const f32x4*)(x + cc * 8 + 4)); }
#pragma unroll
          for (int q = 0; q < 4; ++q) { const size_t cc = c + (size_t)q * NGT; u32x4 o; o.x = pk2(v0[q].x, v0[q].y); o.y = pk2(v0[q].z, v0[q].w); o.z = pk2(v1[q].x, v1[q].y); o.w = pk2(v1[q].z, v1[q].w); *(u32x4*)(XB + cc * 8) = o; } } }
}

template <bool IN16> __device__ __forceinline__ void ln_pass(Frame& F, const void* in, const bf16* add, float* out, bf16* outb, const float* w, const float* b) {
    for (int m0 = 2 * F.gw; m0 < M; m0 += 2 * F.NGW) {
        f32x4 v[2][8]; u32x2 av[2][8], iv[2][8]; float s[2] = {0.f, 0.f};
#pragma unroll
        for (int r = 0; r < 2; ++r) { const u32x2* ar = (const u32x2*)(add + (size_t)(m0 + r) * D) + F.lane;
#pragma unroll
            for (int j = 0; j < 8; ++j) { av[r][j] = __builtin_nontemporal_load(ar + 64 * j);
                if (IN16) iv[r][j] = __builtin_nontemporal_load((const u32x2*)((const bf16*)in + (size_t)(m0 + r) * D) + F.lane + 64 * j);
                else v[r][j] = __builtin_nontemporal_load((const f32x4*)((const float*)in + (size_t)(m0 + r) * D) + F.lane + 64 * j); } }
#pragma unroll
        for (int r = 0; r < 2; ++r) {
#pragma unroll
            for (int j = 0; j < 8; ++j) { if (IN16) v[r][j] = (f32x4){bf_lo(iv[r][j].x), bf_hi(iv[r][j].x), bf_lo(iv[r][j].y), bf_hi(iv[r][j].y)};
                v[r][j] = v[r][j] * ALPHA + (f32x4){bf_lo(av[r][j].x), bf_hi(av[r][j].x), bf_lo(av[r][j].y), bf_hi(av[r][j].y)}; s[r] += (v[r][j].x + v[r][j].y) + (v[r][j].z + v[r][j].w); }
            const float mean = wave_sum(s[r]) * (1.f / D); float s2 = 0.f;
#pragma unroll
            for (int j = 0; j < 8; ++j) { v[r][j] = v[r][j] - mean; s2 += (v[r][j].x * v[r][j].x + v[r][j].y * v[r][j].y) + (v[r][j].z * v[r][j].z + v[r][j].w * v[r][j].w); }
            const float rstd = 1.f / sqrtf(wave_sum(s2) * (1.f / D) + LN_EPS);
#pragma unroll
            for (int j = 0; j < 8; ++j) { const f32x4 wv = ((const f32x4*)w)[64 * j + F.lane], bv = ((const f32x4*)b)[64 * j + F.lane];
                const f32x4 q = v[r][j] * rstd * wv + bv;
                if (out) __builtin_nontemporal_store(q, (f32x4*)(out + (size_t)(m0 + r) * D) + F.lane + 64 * j);
                if (outb) { u32x2 p; p.x = pk2(q.x, q.y); p.y = pk2(q.z, q.w); __builtin_nontemporal_store(p, (u32x2*)(outb + (size_t)(m0 + r) * D) + 64 * j + F.lane); } }
        }
    }
}

__device__ __forceinline__ void p2a_prep(Frame& F, const Args& a) {
    const bf16* HA = (const bf16*)(F.ws + WS_HA); bf16* AP = (bf16*)((unsigned char*)F.out + OUT_AP);
    const int j0 = 4 * F.lane; const f32x4 mu4 = *(const f32x4*)(a.in[2] + 3072 + j0);
#pragma unroll 2
    for (int m = F.gw; m < M; m += F.NGW) {
        const int t = m & (T - 1);
        const u32x2 cur = *(const u32x2*)(HA + (size_t)m * NA + 3072 + j0); u32x2 prv = (u32x2){0u, 0u};
        if (t > 0) prv = *(const u32x2*)(HA + (size_t)(m - 1) * NA + 3072 + j0);
        float c[4] = {bf_lo(cur.x), bf_hi(cur.x), bf_lo(cur.y), bf_hi(cur.y)}, p[4] = {bf_lo(prv.x), bf_hi(prv.x), bf_lo(prv.y), bf_hi(prv.y)};
        const float mu[4] = {mu4.x, mu4.y, mu4.z, mu4.w}; float f[4];
#pragma unroll
        for (int e = 0; e < 4; ++e) { float v = c[e] + (p[e] - c[e]) * mu[e];
            if (F.lane < 16) v = 1.f - 2.f / (1.f + __expf(2.f * v));
            else if (F.lane >= 32) v = sigmoidf_(v);
            f[e] = v; }
        u32x2 o; o.x = pk2(f[0], f[1]); o.y = pk2(f[2], f[3]); *(u32x2*)(AP + (size_t)m * NLORA + j0) = o;
    }
}
__device__ __forceinline__ void ret_rotary(Frame& F, int w, int nw) {
    bf16* HB = (bf16*)(F.ws + WS_HB);
    const float if0 = 1.0f / exp2f((float)F.lane * (13.287712379549449f / 127.0f)), if1 = 1.0f / exp2f((float)(64 + F.lane) * (13.287712379549449f / 127.0f));
    for (int m = w; m < M; m += nw) {
        const int t = m & (T - 1);
        const float th0 = (float)t * if0, th1 = (float)t * if1;
        const double r0 = (double)th0 * 0.15915494309189535, r1 = (double)th1 * 0.15915494309189535;
        const float f0 = (float)(r0 - __builtin_rint(r0)), f1 = (float)(r1 - __builtin_rint(r1));
        const float c0 = __builtin_amdgcn_cosf(f0), s0 = __builtin_amdgcn_sinf(f0), c1 = __builtin_amdgcn_cosf(f1), s1 = __builtin_amdgcn_sinf(f1);
        unsigned qv[8], kv[8];
#pragma unroll
        for (int it = 0; it < 8; ++it) { const int p = it * 64 + F.lane, hd = p >> 7, i = p & 127;
            qv[it] = *(const unsigned*)(HB + (size_t)m * NB + hd * 256 + 2 * i); kv[it] = *(const unsigned*)(HB + (size_t)m * NB + 1024 + hd * 256 + 2 * i); }
#pragma unroll
        for (int it = 0; it < 8; ++it) { const int p = it * 64 + F.lane, hd = p >> 7, i = p & 127; const float cs = (it & 1) ? c1 : c0, sn = (it & 1) ? s1 : s0;
            const float q1 = bf_lo(qv[it]), q2 = bf_hi(qv[it]), k1 = bf_lo(kv[it]), k2 = bf_hi(kv[it]);
            *(unsigned*)(HB + (size_t)m * NB + hd * 256 + 2 * i) = pk2(q1 * cs - q2 * sn, q1 * sn + q2 * cs);
            *(unsigned*)(HB + (size_t)m * NB + 1024 + hd * 256 + 2 * i) = pk2((k1 * cs - k2 * sn) * 0.0625f, (k1 * sn + k2 * cs) * 0.0625f); }
    }
}
#define XB_TMO      128
#define XB_XCNT(j)  (256  + 64 * (j))
#define XB_XSUB(j)  (1280 + 64 * (j))
#define XB_XGEN(j)  (2304 + 64 * (j))
#define XB_TOP      3328
#define XB_TOPGEN   3392
#define XCD_BAR_WORDS 3456
#define XB_SPIN_CAP (1u << 18)

__device__ __forceinline__ unsigned xb_ld(unsigned* p)              { return __hip_atomic_load(p, __ATOMIC_RELAXED, __HIP_MEMORY_SCOPE_AGENT); }
__device__ __forceinline__ unsigned xb_add(unsigned* p, unsigned v) { return __hip_atomic_fetch_add(p, v, __ATOMIC_RELAXED, __HIP_MEMORY_SCOPE_AGENT); }
__device__ __forceinline__ unsigned xb_xcc_id() { return (unsigned)__builtin_amdgcn_s_getreg((3 << 11) | 20) & 0xFu; }
#define XB_SPIN(cond, bar) do { unsigned _sp = 0; while (cond) { __builtin_amdgcn_s_sleep(1); \
    if ((++_sp & 255u) == 0u) { if (xb_ld(&(bar)[XB_TMO])) break; if (_sp > XB_SPIN_CAP) { atomicAdd(&(bar)[XB_TMO], 1u); break; } } } } while (0)

struct XcdBarrier {
    unsigned* bar; unsigned x;
    volatile LAS unsigned* st;
};

__device__ __forceinline__ XcdBarrier xcd_barrier_post(unsigned* bar, volatile LAS unsigned* st) {
    XcdBarrier b; b.bar = bar; b.x = xb_xcc_id(); b.st = st;
    if (threadIdx.x == 0) (void)xb_add(&bar[XB_XCNT(b.x)], 1u);
    return b;
}
__device__ __forceinline__ void xcd_barrier_complete(unsigned* bar, unsigned x, unsigned& nloc, unsigned& nx) {
    const unsigned G = gridDim.x * gridDim.y * gridDim.z;
    unsigned sum, cnt, mine, sp = 0u;
    for (;;) {
        sum = 0u; cnt = 0u; mine = 0u;
#pragma unroll
        for (unsigned j = 0; j < 16; ++j) { const unsigned c = xb_ld(&bar[XB_XCNT(j)]); sum += c; cnt += (c > 0u) ? 1u : 0u; mine = (j == x) ? c : mine; }
        if (sum == G) break;
        __builtin_amdgcn_s_sleep(1);
        if ((++sp & 255u) == 0u) { if (xb_ld(&bar[XB_TMO])) break; if (sp > XB_SPIN_CAP) { atomicAdd(&bar[XB_TMO], 1u); break; } }
    }
    nloc = mine > 0u ? mine : 1u; nx = cnt > 0u ? cnt : 1u;
}

__device__ __forceinline__ void xcd_barrier(const XcdBarrier& b) {
    asm volatile("s_waitcnt vmcnt(0)" ::: "memory");
    __syncthreads();
    if (threadIdx.x == 0) {
        unsigned* bar = b.bar;
        __builtin_amdgcn_s_waitcnt(0);
        unsigned nloc = b.st[0], nx = b.st[1];
        if (nloc == 0u) { xcd_barrier_complete(bar, b.x, nloc, nx); b.st[0] = nloc; b.st[1] = nx; }
        const unsigned old = xb_add(&bar[XB_XSUB(b.x)], 1u);
        const unsigned gen = old / nloc;
        if (old + 1u == (gen + 1u) * nloc) {
            __builtin_amdgcn_fence(__ATOMIC_RELEASE, "agent");
            asm volatile("s_waitcnt vmcnt(0)" ::: "memory");
            const unsigned og = xb_add(&bar[XB_TOP], 1u);
            const unsigned tg = og / nx;
            if (og + 1u == (tg + 1u) * nx) xb_add(&bar[XB_TOPGEN], 1u);
            else XB_SPIN(xb_ld(&bar[XB_TOPGEN]) == tg, bar);
            __builtin_amdgcn_fence(__ATOMIC_ACQUIRE, "agent");
            xb_add(&bar[XB_XGEN(b.x)], 1u);
            asm volatile("s_waitcnt vmcnt(0)" ::: "memory");
        } else {
            XB_SPIN(xb_ld(&bar[XB_XGEN(b.x)]) == gen, bar);
            __builtin_amdgcn_fence(__ATOMIC_ACQUIRE, "agent");
            asm volatile("s_waitcnt vmcnt(0)" ::: "memory");
        }
    }
    __syncthreads();
}

__device__ __forceinline__ void sub_barrier(unsigned* ctr, unsigned target) {
    asm volatile("s_waitcnt vmcnt(0)" ::: "memory");
    __syncthreads();
    if (threadIdx.x == 0) {
        __builtin_amdgcn_fence(__ATOMIC_RELEASE, "agent");
        asm volatile("s_waitcnt vmcnt(0)" ::: "memory");
        __hip_atomic_fetch_add(ctr, 1u, __ATOMIC_RELAXED, __HIP_MEMORY_SCOPE_AGENT);
        while (__hip_atomic_load(ctr, __ATOMIC_RELAXED, __HIP_MEMORY_SCOPE_AGENT) < target) __builtin_amdgcn_s_sleep(2);
        __builtin_amdgcn_fence(__ATOMIC_ACQUIRE, "agent");
        asm volatile("s_waitcnt vmcnt(0)" ::: "memory");
    }
    __syncthreads();
}

struct Prep { f16b *r, *x, *km, *v, *kk, *b; float* bon; };
__device__ __forceinline__ Prep prep_ptrs(Frame& F) { Prep p; f16b* o = (f16b*)F.out; const size_t S = (size_t)M * DR;
    p.r = o; p.x = o + S; p.km = o + 2 * S; p.v = o + 3 * S; p.kk = (f16b*)(F.ws + WS_P5); p.b = (f16b*)(F.ws + WS_P6); p.bon = (float*)(F.ws + WS_BON); return p; }
__device__ __forceinline__ void p2c_rwkv_prep(Frame& F, const Args& a) {
    const bf16* HA = (const bf16*)(F.ws + WS_HA); const f16b* LRW = (const f16b*)(F.ws + WS_LRW); const f16b* LRA = (const f16b*)(F.ws + WS_LRA);
    const Prep P = prep_ptrs(F);
    const int qd = F.gw & 3, c0 = 256 * qd + 4 * F.lane, hd = c0 >> 6;
    const f32x4 mu_r = *(const f32x4*)(a.in[2] + c0), mu_k = *(const f32x4*)(a.in[2] + 1024 + c0), mu_v = *(const f32x4*)(a.in[2] + 2048 + c0);
    const f32x4 w0 = *(const f32x4*)(a.in[3] + c0), a0 = *(const f32x4*)(a.in[5] + c0), k_k = *(const f32x4*)(a.in[8] + c0), k_a = *(const f32x4*)(a.in[9] + c0), r_k = *(const f32x4*)(a.in[10] + c0);
    const int NI = F.NGW >> 2;
#pragma unroll 4
    for (int m = F.gw >> 2; m < M; m += NI) {
        const int t = m & (T - 1); const bf16* row = HA + (size_t)m * NA + c0; const size_t o = (size_t)m * DR + c0;
        const u32x2 cr = *(const u32x2*)(row), ck = *(const u32x2*)(row + 1024), cv = *(const u32x2*)(row + 2048);
        u32x2 pr = (u32x2){0u, 0u}, pk = pr, pv = pr;
        if (t > 0) { pr = *(const u32x2*)(row - NA); pk = *(const u32x2*)(row - NA + 1024); pv = *(const u32x2*)(row - NA + 2048); }
        const u32x2 lw = __builtin_nontemporal_load((const u32x2*)(LRW + o)), la = __builtin_nontemporal_load((const u32x2*)(LRA + o));
        float r[4], k[4], v[4], x[4], as[4], kk[4], km[4]; float n2 = 0.f, bon = 0.f;
#pragma unroll
        for (int e = 0; e < 4; ++e) {
            const unsigned wr_ = cr[e >> 1], wk_ = ck[e >> 1], wv_ = cv[e >> 1], qr_ = pr[e >> 1], qk_ = pk[e >> 1], qv_ = pv[e >> 1];
            const float hr = (e & 1) ? bf_hi(wr_) : bf_lo(wr_), hk = (e & 1) ? bf_hi(wk_) : bf_lo(wk_), hv = (e & 1) ? bf_hi(wv_) : bf_lo(wv_);
            const float gr = (e & 1) ? bf_hi(qr_) : bf_lo(qr_), gk = (e & 1) ? bf_hi(qk_) : bf_lo(qk_), gv = (e & 1) ? bf_hi(qv_) : bf_lo(qv_);
            r[e] = hr + (gr - hr) * mu_r[e]; k[e] = hk + (gk - hk) * mu_k[e]; v[e] = hv + (gv - hv) * mu_v[e];
            const float wpre = w0[e] + ((e & 1) ? h_hi(lw[e >> 1]) : h_lo(lw[e >> 1])), apre = a0[e] + ((e & 1) ? h_hi(la[e >> 1]) : h_lo(la[e >> 1]));
            const float z = -wpre; const float sp = fmaxf(z, 0.f) + __logf(1.f + __expf(-fabsf(z)));
            const float ew = __expf(-sp - 0.5f); x[e] = 1.f - __expf(-ew);
            as[e] = sigmoidf_(apre); kk[e] = k[e] * k_k[e]; n2 += kk[e] * kk[e];
            km[e] = k[e] * (1.f + (as[e] - 1.f) * k_a[e]); bon += r[e] * km[e] * r_k[e]; }
        n2 = row16_sum(n2); bon = row16_sum(bon);
        const float inv = 1.f / fmaxf(sqrtf(n2), 1e-12f);
#pragma unroll
        for (int e = 0; e < 4; ++e) kk[e] *= inv;
        __builtin_nontemporal_store((u32x2){pkh(r[0], r[1]), pkh(r[2], r[3])}, (u32x2*)(P.r + o)); __builtin_nontemporal_store((u32x2){pkh(x[0], x[1]), pkh(x[2], x[3])}, (u32x2*)(P.x + o));
        __builtin_nontemporal_store((u32x2){pkh(km[0], km[1]), pkh(km[2], km[3])}, (u32x2*)(P.km + o)); __builtin_nontemporal_store((u32x2){pkh(v[0], v[1]), pkh(v[2], v[3])}, (u32x2*)(P.v + o));
        __builtin_nontemporal_store((u32x2){pkh(kk[0], kk[1]), pkh(kk[2], kk[3])}, (u32x2*)(P.kk + o)); __builtin_nontemporal_store((u32x2){pkh(kk[0] * as[0], kk[1] * as[1]), pkh(kk[2] * as[2], kk[3] * as[3])}, (u32x2*)(P.b + o));
        if ((F.lane & 15) == 0) P.bon[(size_t)m * 16 + hd] = bon;
    }
}
constexpr int RC = 32;
constexpr int RB_VEC = 0, RB_SCL = 16 * 9 * 64, RB_V = RB_SCL + 16 * 12, RB_Y = RB_V + RC * 16, RB_FLOATS = RB_Y + RC * 256;
static_assert(2 * RB_FLOATS * 4 <= LDS_BYTES, "rwkv scan LDS");
__device__ __forceinline__ void rwkv_scan_unit(Frame& F, int unit) {
    const int bh = unit >> 2, rg = unit & 3, b = bh >> 4, h = bh & 15; const size_t m0 = (size_t)b * T; const int ch0 = h * 64;
    const Prep P = prep_ptrs(F); bf16* MIX = (bf16*)(F.ws + WS_MIX);
    LAS float* L = (LAS float*)F.lds;
    constexpr int NCH = T / RC;
    if (F.wave >= 4) {
        const int ht = F.tid - 256, pp = ht >> 4, c4 = (ht & 15) * 4, s = ht >> 3, c8 = ht & 7;
        u32x2 qr[2][2], qx[2][2], qk[2][2], qa[2][2], qb[2][2]; unsigned qv[2];
#define RW_LOAD(c, S_) do { \
        _Pragma("unroll") for (int u_ = 0; u_ < 2; ++u_) { const size_t o_ = (m0 + (size_t)(c) * RC + 2 * pp + u_) * DR + ch0 + c4; \
            qr[S_][u_] = *(const u32x2*)(P.r + o_); qx[S_][u_] = *(const u32x2*)(P.x + o_); qk[S_][u_] = *(const u32x2*)(P.km + o_); qa[S_][u_] = *(const u32x2*)(P.kk + o_); qb[S_][u_] = *(const u32x2*)(P.b + o_); } \
        qv[S_] = *(const unsigned*)(P.v + (m0 + (size_t)(c) * RC + s) * DR + ch0 + 16 * rg + 2 * c8); } while (0)
#define RW_WRITE(buf, S_) do { LAS float* B_ = L + (buf) * RB_FLOATS; float c1_ = 0.f, c2_ = 0.f, br0_ = 0.f, kr0_ = 0.f, d1_ = 0.f, d2_ = 0.f, br1_ = 0.f, kr1_ = 0.f; \
        f32x4 o_[9]; \
        _Pragma("unroll") for (int e_ = 0; e_ < 4; ++e_) { \
            const unsigned wr0u = qr[S_][0][e_ >> 1], wx0u = qx[S_][0][e_ >> 1], wk0u = qk[S_][0][e_ >> 1], wa0u = qa[S_][0][e_ >> 1], wb0u = qb[S_][0][e_ >> 1]; \
            const unsigned wr1u = qr[S_][1][e_ >> 1], wx1u = qx[S_][1][e_ >> 1], wk1u = qk[S_][1][e_ >> 1], wa1u = qa[S_][1][e_ >> 1], wb1u = qb[S_][1][e_ >> 1]; \
            const float r0 = (e_ & 1) ? h_hi(wr0u) : h_lo(wr0u), w0 = 1.f - ((e_ & 1) ? h_hi(wx0u) : h_lo(wx0u)), k0 = (e_ & 1) ? h_hi(wk0u) : h_lo(wk0u), a0 = (e_ & 1) ? h_hi(wa0u) : h_lo(wa0u), b0 = (e_ & 1) ? h_hi(wb0u) : h_lo(wb0u); \
            const float r1 = (e_ & 1) ? h_hi(wr1u) : h_lo(wr1u), w1 = 1.f - ((e_ & 1) ? h_hi(wx1u) : h_lo(wx1u)), k1 = (e_ & 1) ? h_hi(wk1u) : h_lo(wk1u), a1 = (e_ & 1) ? h_hi(wa1u) : h_lo(wa1u), b1 = (e_ & 1) ? h_hi(wb1u) : h_lo(wb1u); \
            const float wr1 = w1 * r1; \
            o_[0][e_] = a0; o_[1][e_] = w0 * r0; o_[2][e_] = w0 * a1; o_[3][e_] = w0 * wr1; o_[4][e_] = w0 * w1; o_[5][e_] = k0 * w1; o_[6][e_] = b0 * w1; o_[7][e_] = k1; o_[8][e_] = b1; \
            c1_ += b0 * a1; c2_ += k0 * a1; br0_ += b0 * r0; kr0_ += k0 * r0; d1_ += b0 * wr1; d2_ += k0 * wr1; br1_ += b1 * r1; kr1_ += k1 * r1; } \
        _Pragma("unroll") for (int j_ = 0; j_ < 9; ++j_) *(LAS f32x4*)(B_ + RB_VEC + (pp * 9 + j_) * 64 + c4) = o_[j_]; \
        c1_ = row16_sum(c1_); c2_ = row16_sum(c2_); br0_ = row16_sum(br0_); kr0_ = row16_sum(kr0_); d1_ = row16_sum(d1_); d2_ = row16_sum(d2_); br1_ = row16_sum(br1_); kr1_ = row16_sum(kr1_); \
        if ((ht & 15) == 0) { *(LAS f32x4*)(B_ + RB_SCL + pp * 12) = (f32x4){c1_, c2_, br0_ * 0.0625f, kr0_ * 0.0625f}; *(LAS f32x4*)(B_ + RB_SCL + pp * 12 + 4) = (f32x4){d1_ * 0.0625f, d2_ * 0.0625f, br1_ * 0.0625f, kr1_ * 0.0625f}; } \
        *(LAS f32x2*)(B_ + RB_V + s * 16 + 2 * c8) = (f32x2){h_lo(qv[S_]), h_hi(qv[S_])}; } while (0)
#define RW_STOREY(buf, c) do { const LAS float* B_ = L + (buf) * RB_FLOATS; float y_[2]; \
        _Pragma("unroll") for (int q_ = 0; q_ < 2; ++q_) { const LAS f32x4* yp_ = (const LAS f32x4*)(B_ + RB_Y + (s * 16 + 2 * c8 + q_) * 16); \
            const f32x4 a_ = yp_[0], b_ = yp_[1], c_ = yp_[2], d_ = yp_[3]; \
            y_[q_] = ((a_.x + a_.y) + (a_.z + a_.w)) + ((b_.x + b_.y) + (b_.z + b_.w)) + (((c_.x + c_.y) + (c_.z + c_.w)) + ((d_.x + d_.y) + (d_.z + d_.w))); } \
        *(unsigned*)(MIX + (m0 + (size_t)(c) * RC + s) * D + ch0 + 16 * rg + 2 * c8) = pk2(y_[0], y_[1]); } while (0)
        RW_LOAD(0, 0); RW_WRITE(0, 0); RW_LOAD(1, 1); RW_LOAD(2, 0);
        __syncthreads();
        for (int c = 0; c < NCH; c += 2) {
            if (c + 1 < NCH) RW_WRITE(1, 1);
            if (c + 3 < NCH) RW_LOAD(c + 3, 1);
            if (c > 0) RW_STOREY(1, c - 1);
            __syncthreads();
            if (c + 2 < NCH) RW_WRITE(0, 0);
            if (c + 4 < NCH) RW_LOAD(c + 4, 0);
            RW_STOREY(0, c);
            __syncthreads();
        }
        RW_STOREY((NCH - 1) & 1, NCH - 1);
#undef RW_LOAD
#undef RW_WRITE
#undef RW_STOREY
    } else {
        const int g4 = F.lane >> 4, l = F.lane & 15, vrow = F.wave * 4 + g4;
        f32x2 Sa = (f32x2){0.f, 0.f}, Sb = (f32x2){0.f, 0.f};
        struct PairV { f32x4 v[9]; f32x4 sa, sb; float vv0, vv1; };
#define SC_LD(d, p_) do { _Pragma("unroll") for (int j_ = 0; j_ < 9; ++j_) d.v[j_] = *(const LAS f32x4*)(B + RB_VEC + ((p_) * 9 + j_) * 64 + 4 * l); \
        d.sa = *(const LAS f32x4*)(B + RB_SCL + (p_) * 12); d.sb = *(const LAS f32x4*)(B + RB_SCL + (p_) * 12 + 4); d.vv0 = B[RB_V + (2 * (p_)) * 16 + vrow]; d.vv1 = B[RB_V + (2 * (p_) + 1) * 16 + vrow]; } while (0)
#define LO2(q_) ((f32x2){(q_).x, (q_).y})
#define HI2(q_) ((f32x2){(q_).z, (q_).w})
#define SC_PAIR(d, p_) do { \
        const f32x2 t1 = Sa * LO2(d.v[0]) + Sb * HI2(d.v[0]), t2 = Sa * LO2(d.v[1]) + Sb * HI2(d.v[1]), t3 = Sa * LO2(d.v[2]) + Sb * HI2(d.v[2]), t4 = Sa * LO2(d.v[3]) + Sb * HI2(d.v[3]); \
        const float p1 = row16_sum(t1.x + t1.y), r3 = row16_sum(t3.x + t3.y); \
        const float p1n = r3 - p1 * d.sa.x + d.vv0 * d.sa.y; \
        Y[(2 * (p_)) * 256 + vrow * 16 + l] = (t2.x + t2.y) + (d.vv0 * d.sa.w - p1 * d.sa.z); \
        Y[(2 * (p_) + 1) * 256 + vrow * 16 + l] = (t4.x + t4.y) + ((d.vv0 * d.sb.y - p1 * d.sb.x) + (d.vv1 * d.sb.w - p1n * d.sb.z)); \
        const f32x2 ea = (LO2(d.v[5]) * d.vv0 - LO2(d.v[6]) * p1) + (LO2(d.v[7]) * d.vv1 - LO2(d.v[8]) * p1n), eb = (HI2(d.v[5]) * d.vv0 - HI2(d.v[6]) * p1) + (HI2(d.v[7]) * d.vv1 - HI2(d.v[8]) * p1n); \
        Sa = Sa * LO2(d.v[4]) + ea; Sb = Sb * HI2(d.v[4]) + eb; } while (0)
        __syncthreads();
        for (int c = 0; c < NCH; ++c) {
            const LAS float* B = L + (c & 1) * RB_FLOATS; LAS float* Y = L + (c & 1) * RB_FLOATS + RB_Y;
            PairV a0, a1;
            SC_LD(a0, 0);
#pragma unroll
            for (int p = 0; p < RC / 2; p += 2) {
                SC_LD(a1, p + 1);
                SC_PAIR(a0, p);
                if (p + 2 < RC / 2) SC_LD(a0, p + 2);
                SC_PAIR(a1, p + 1);
            }
            __syncthreads();
        }
#undef SC_LD
#undef SC_PAIR
#undef LO2
#undef HI2
    }
}

constexpr size_t WS_KT = 896 * MiB, WS_VT = 960 * MiB;
constexpr int TR_P = 136;
static_assert(2 * 256 * TR_P * 2 <= LDS_BYTES, "transpose LDS");
__device__ __forceinline__ float ret_lg2gamma(int h) { return log2f(1.0f - exp2f(-5.0f - (float)h)); }
__device__ __forceinline__ void ret_transpose_unit(Frame& F, int unit) {
    const int n = unit & 127, bh = unit >> 7, b = bh >> 2, h = bh & 3;
    const bf16* HB = (const bf16*)(F.ws + WS_HB); bf16* KT = (bf16*)(F.ws + WS_KT) + (size_t)unit * 32768; bf16* VT = (bf16*)(F.ws + WS_VT) + (size_t)unit * 32768;
    LAS bf16* TK = (LAS bf16*)F.lds; LAS bf16* TV = TK + 256 * TR_P;
    const int w = F.wave, cl = F.lane & 15, dq = F.lane >> 4, c = 16 * w + cl;
    const float dk = exp2f((float)(127 - c) * ret_lg2gamma(h));
    const size_t r0 = (size_t)b * T + (size_t)n * 128;
    u32x4 kreg[8], vreg[8];
#pragma unroll
    for (int i = 0; i < 8; ++i) { kreg[i] = *(const u32x4*)(HB + (r0 + c) * NB + 1024 + h * 256 + (4 * i + dq) * 8); vreg[i] = *(const u32x4*)(HB + (r0 + c) * NB + 2048 + h * 256 + (4 * i + dq) * 8); }
#pragma unroll
    for (int i = 0; i < 8; ++i) { const int d0 = (4 * i + dq) * 8;
#pragma unroll
        for (int e = 0; e < 4; ++e) { TK[(d0 + 2 * e) * TR_P + c] = (bf16)f2bf(bf_lo(kreg[i][e]) * dk); TK[(d0 + 2 * e + 1) * TR_P + c] = (bf16)f2bf(bf_hi(kreg[i][e]) * dk);
            TV[(d0 + 2 * e) * TR_P + c] = (bf16)(vreg[i][e] & 0xffffu); TV[(d0 + 2 * e + 1) * TR_P + c] = (bf16)(vreg[i][e] >> 16); } }
    __syncthreads();
#pragma unroll
    for (int i = 0; i < 8; ++i) { const int idx = i * 512 + F.tid, d = idx >> 4, chk = idx & 15;
        *(u32x4*)(KT + d * 128 + 8 * chk) = *(const LAS u32x4*)(TK + d * TR_P + 8 * chk); *(u32x4*)(VT + d * 128 + 8 * chk) = *(const LAS u32x4*)(TV + d * TR_P + 8 * chk); }
    __syncthreads();
}
constexpr int KT_P = 136, RT_P = 264;
constexpr int RS_KT = 0, RS_VT = 256 * KT_P * 2, RS_RT = RS_VT + 32 * KT_P * 2, RS_END = RS_RT + 32 * RT_P * 2;
static_assert(RS_END <= LDS_BYTES, "retention scan LDS");
__device__ __forceinline__ void ret_scan_unit(Frame& F, int ru) {
    const int bh = ru >> 3, es = ru & 7, b = bh >> 2, h = bh & 3, e0 = 32 * es;
    const bf16* HB = (const bf16*)(F.ws + WS_HB); bf16* MIX = (bf16*)(F.ws + WS_MIX);
    LAS bf16* KT = (LAS bf16*)(F.lds + RS_KT); LAS bf16* VT = (LAS bf16*)(F.lds + RS_VT); LAS bf16* RT = (LAS bf16*)(F.lds + RS_RT);
    const float lg = ret_lg2gamma(h); const float g128 = exp2f(128.f * lg);
    const int w = F.wave, lane = F.lane, cl = lane & 15, dq = lane >> 4;
    const bf16* KTg = (const bf16*)(F.ws + WS_KT) + (size_t)bh * 128 * 32768; const bf16* VTg = (const bf16*)(F.ws + WS_VT) + (size_t)bh * 128 * 32768;
    for (int i = F.tid; i < 32 * RT_P / 2; i += 512) ((LAS unsigned*)RT)[i] = 0u;
    pg8::f32x4 acc[2][2];
#pragma unroll
    for (int i = 0; i < 2; ++i)
#pragma unroll
        for (int j = 0; j < 2; ++j) acc[i][j] = (pg8::f32x4){0.f, 0.f, 0.f, 0.f};
    u32x4 kreg[8], vreg, qreg[8];
    const size_t mb = (size_t)b * T;
#define RS_LOAD(n) do { const size_t r0_ = mb + (size_t)(n) * 128; \
        _Pragma("unroll") for (int i_ = 0; i_ < 8; ++i_) { const int idx_ = i_ * 512 + F.tid; kreg[i_] = *(const u32x4*)(KTg + (size_t)(n) * 32768 + (idx_ >> 4) * 128 + 8 * (idx_ & 15)); } \
        vreg = *(const u32x4*)(VTg + (size_t)(n) * 32768 + (e0 + (F.tid >> 4)) * 128 + 8 * (F.tid & 15)); \
        _Pragma("unroll") for (int k_ = 0; k_ < 8; ++k_) qreg[k_] = *(const u32x4*)(HB + (r0_ + 16 * w + cl) * NB + h * 256 + 32 * k_ + dq * 8); } while (0)
    RS_LOAD(0);
    for (int n = 0; n < T / 128; ++n) {
#pragma unroll
        for (int i = 0; i < 8; ++i) { const int idx = i * 512 + F.tid; *(LAS u32x4*)(KT + (idx >> 4) * KT_P + 8 * (idx & 15)) = kreg[i]; }
        *(LAS u32x4*)(VT + (F.tid >> 4) * KT_P + 8 * (F.tid & 15)) = vreg;
        __syncthreads();
        bf16x8 qcur[8];
#pragma unroll
        for (int k_ = 0; k_ < 8; ++k_) qcur[k_] = __builtin_bit_cast(bf16x8, qreg[k_]);
        if (n + 1 < T / 128) RS_LOAD(n + 1);
        { pg8::f32x4 cx[2] = {(pg8::f32x4){0.f, 0.f, 0.f, 0.f}, (pg8::f32x4){0.f, 0.f, 0.f, 0.f}};
#pragma unroll
          for (int ks = 0; ks < 8; ++ks)
#pragma unroll
              for (int et = 0; et < 2; ++et) { const bf16x8 Bf = *(const LAS bf16x8*)(RT + (16 * et + cl) * RT_P + 32 * ks + dq * 8);
                  cx[et] = __builtin_amdgcn_mfma_f32_16x16x32_bf16(qcur[ks], Bf, cx[et], 0, 0, 0); }
#pragma unroll
          for (int r = 0; r < 4; ++r) { const int c = 16 * w + dq * 4 + r; const float qd = exp2f((float)(c + 1) * lg);
#pragma unroll
              for (int et = 0; et < 2; ++et) MIX[(mb + (size_t)n * 128 + c) * D + DR + h * 256 + e0 + 16 * et + cl] = (bf16)f2bf(cx[et][r] * qd); } }
#pragma unroll
        for (int dt = 0; dt < 2; ++dt)
#pragma unroll
            for (int et = 0; et < 2; ++et) acc[dt][et] = acc[dt][et] * g128;
#pragma unroll
        for (int kc = 0; kc < 4; ++kc) { bf16x8 Af[2], Bf[2];
#pragma unroll
            for (int dt = 0; dt < 2; ++dt) Af[dt] = *(const LAS bf16x8*)(KT + (32 * w + 16 * dt + cl) * KT_P + 32 * kc + dq * 8);
#pragma unroll
            for (int et = 0; et < 2; ++et) Bf[et] = *(const LAS bf16x8*)(VT + (16 * et + cl) * KT_P + 32 * kc + dq * 8);
#pragma unroll
            for (int dt = 0; dt < 2; ++dt)
#pragma unroll
                for (int et = 0; et < 2; ++et) acc[dt][et] = __builtin_amdgcn_mfma_f32_16x16x32_bf16(Af[dt], Bf[et], acc[dt][et], 0, 0, 0); }
        __syncthreads();
#pragma unroll
        for (int dt = 0; dt < 2; ++dt)
#pragma unroll
            for (int et = 0; et < 2; ++et) { u32x2 p; p.x = pk2(acc[dt][et][0], acc[dt][et][1]); p.y = pk2(acc[dt][et][2], acc[dt][et][3]);
                *(LAS u32x2*)(RT + (16 * et + cl) * RT_P + 32 * w + 16 * dt + dq * 4) = p; }
    }
#undef RS_LOAD
    __syncthreads();
}
constexpr int KS_P = 264, VT_P = 136, PW_P = 136;
constexpr int RI_KS = 0, RI_VT = 128 * KS_P * 2, RI_END = RI_VT + 256 * VT_P * 2;
static_assert(RI_END <= LDS_BYTES && 8 * 16 * PW_P * 2 <= RI_VT, "retention intra LDS");
__device__ __forceinline__ void ret_intra_unit(Frame& F, const Args& a, int unit) {
    const int n = unit & 127, bh = unit >> 7, b = bh >> 2, h = bh & 3;
    const bf16* HB = (const bf16*)(F.ws + WS_HB); bf16* MIX = (bf16*)(F.ws + WS_MIX);
    LAS bf16* KS = (LAS bf16*)(F.lds + RI_KS); LAS bf16* VT = (LAS bf16*)(F.lds + RI_VT);
    const int w = F.wave, lane = F.lane, cl = lane & 15, dq = lane >> 4;
    const float lg = ret_lg2gamma(h);
    const size_t r0 = (size_t)b * T + (size_t)n * 128;
#pragma unroll
    for (int i = 0; i < 8; ++i) { const int idx = i * 512 + F.tid, c = idx >> 5, chk = idx & 31;
        *(LAS u32x4*)(KS + c * KS_P + 8 * chk) = *(const u32x4*)(HB + (r0 + c) * NB + 1024 + h * 256 + 8 * chk); }
    { const bf16* VTg = (const bf16*)(F.ws + WS_VT) + (size_t)unit * 32768;
#pragma unroll
      for (int i = 0; i < 8; ++i) { const int idx = i * 512 + F.tid, e = idx >> 4, chk = idx & 15; *(LAS u32x4*)(VT + e * VT_P + 8 * chk) = *(const u32x4*)(VTg + e * 128 + 8 * chk); } }
    bf16x8 qf[8];
#pragma unroll
    for (int ks = 0; ks < 8; ++ks) qf[ks] = __builtin_bit_cast(bf16x8, *(const u32x4*)(HB + (r0 + 16 * w + cl) * NB + h * 256 + 32 * ks + dq * 8));
    __syncthreads();
    pg8::f32x4 s[8];
#pragma unroll
    for (int mt = 0; mt < 8; ++mt) { s[mt] = (pg8::f32x4){0.f, 0.f, 0.f, 0.f};
        if (mt <= w) {
#pragma unroll
            for (int ks = 0; ks < 8; ++ks) { const bf16x8 Bf = *(const LAS bf16x8*)(KS + (16 * mt + cl) * KS_P + 32 * ks + dq * 8);
                s[mt] = __builtin_amdgcn_mfma_f32_16x16x32_bf16(qf[ks], Bf, s[mt], 0, 0, 0); } } }
    __syncthreads();
    LAS bf16* PW = (LAS bf16*)(F.lds) + w * 16 * PW_P;
#pragma unroll
    for (int mt = 0; mt < 8; ++mt)
#pragma unroll
        for (int r = 0; r < 4; ++r) { const int cc = 16 * w + dq * 4 + r, mm = 16 * mt + cl; const float dm = (mm <= cc) ? exp2f((float)(cc - mm) * lg) : 0.f;
            PW[(dq * 4 + r) * PW_P + mm] = (bf16)f2bf(s[mt][r] * dm); }
    LDS_WAIT(); asm volatile("" ::: "memory");
    pg8::f32x4 o[16];
#pragma unroll
    for (int et = 0; et < 16; ++et) o[et] = (pg8::f32x4){0.f, 0.f, 0.f, 0.f};
#pragma unroll
    for (int kc = 0; kc < 4; ++kc) if (kc <= (w >> 1)) { const bf16x8 Af = *(const LAS bf16x8*)(PW + cl * PW_P + 32 * kc + dq * 8);
#pragma unroll
        for (int et = 0; et < 16; ++et) { const bf16x8 Bf = *(const LAS bf16x8*)(VT + (16 * et + cl) * VT_P + 32 * kc + dq * 8);
            o[et] = __builtin_amdgcn_mfma_f32_16x16x32_bf16(Af, Bf, o[et], 0, 0, 0); } }
    const float* gnw = a.in[13] + h * 256;
#pragma unroll
    for (int r = 0; r < 4; ++r) { const size_t row = r0 + 16 * w + dq * 4 + r; bf16* mp = MIX + row * D + DR + h * 256 + cl; const bf16* gp = HB + row * NB + 3072 + h * 256 + cl;
        float sum = 0.f;
#pragma unroll
        for (int et = 0; et < 16; ++et) { o[et][r] += bf1(mp[16 * et]); sum += o[et][r]; }
        const float mean = row16_sum(sum) * (1.f / 256.f); float q = 0.f;
#pragma unroll
        for (int et = 0; et < 16; ++et) { const float d = o[et][r] - mean; q += d * d; }
        const float rstd = 1.f / sqrtf(row16_sum(q) * (1.f / 256.f) + RET_GN_EPS);
#pragma unroll
        for (int et = 0; et < 16; ++et) { const float g = bf1(gp[16 * et]); const float y = (o[et][r] - mean) * rstd * gnw[16 * et + cl] * (g * sigmoidf_(g)); mp[16 * et] = (bf16)f2bf(y); } }
    __syncthreads();
}
__device__ __forceinline__ void rwkv_finalize(Frame& F, const Args& a) {
    const Prep P = prep_ptrs(F); bf16* MIX = (bf16*)(F.ws + WS_MIX); const f16b* G = (const f16b*)(F.ws + WS_G);
    const int c0 = 16 * F.lane, hd = F.lane >> 2;
    float gw_[16], gb_[16];
#pragma unroll
    for (int j = 0; j < 4; ++j) { const f32x4 x = *(const f32x4*)(a.in[11] + c0 + 4 * j), y = *(const f32x4*)(a.in[12] + c0 + 4 * j);
        gw_[4 * j] = x.x; gw_[4 * j + 1] = x.y; gw_[4 * j + 2] = x.z; gw_[4 * j + 3] = x.w; gb_[4 * j] = y.x; gb_[4 * j + 1] = y.y; gb_[4 * j + 2] = y.z; gb_[4 * j + 3] = y.w; }
    for (int m = F.gw; m < M; m += F.NGW) {
        u32x4 yv[2], vv[2], gv[2];
        yv[0] = __builtin_nontemporal_load((const u32x4*)(MIX + (size_t)m * D + c0)); yv[1] = __builtin_nontemporal_load((const u32x4*)(MIX + (size_t)m * D + c0 + 8));
        vv[0] = __builtin_nontemporal_load((const u32x4*)(P.v + (size_t)m * DR + c0)); vv[1] = __builtin_nontemporal_load((const u32x4*)(P.v + (size_t)m * DR + c0 + 8));
        gv[0] = __builtin_nontemporal_load((const u32x4*)(G + (size_t)m * DR + c0)); gv[1] = __builtin_nontemporal_load((const u32x4*)(G + (size_t)m * DR + c0 + 8));
        const float bon = P.bon[(size_t)m * 16 + hd];
        float y[16]; float s = 0.f;
#pragma unroll
        for (int j = 0; j < 8; ++j) { y[2 * j] = bf_lo(yv[j >> 2][j & 3]); y[2 * j + 1] = bf_hi(yv[j >> 2][j & 3]); s += y[2 * j] + y[2 * j + 1]; }
        s += __shfl_xor(s, 1); s += __shfl_xor(s, 2); const float mean = s * (1.f / 64.f); float q = 0.f;
#pragma unroll
        for (int j = 0; j < 16; ++j) { y[j] -= mean; q += y[j] * y[j]; }
        q += __shfl_xor(q, 1); q += __shfl_xor(q, 2); const float rstd = 1.f / sqrtf(q * (1.f / 64.f) + RWKV_GN_EPS);
        u32x4 ov[2];
#pragma unroll
        for (int j = 0; j < 8; ++j) { const unsigned vw = vv[j >> 2][j & 3], gw2 = gv[j >> 2][j & 3];
            const float o0 = (y[2 * j] * rstd * gw_[2 * j] + gb_[2 * j] + bon * h_lo(vw)) * h_lo(gw2);
            const float o1 = (y[2 * j + 1] * rstd * gw_[2 * j + 1] + gb_[2 * j + 1] + bon * h_hi(vw)) * h_hi(gw2);
            ov[j >> 2][j & 3] = pk2(o0, o1); }
        *(u32x4*)(MIX + (size_t)m * D + c0) = ov[0]; *(u32x4*)(MIX + (size_t)m * D + c0 + 8) = ov[1];
    }
}

constexpr int N_PHASES = 12;
__global__ void __launch_bounds__(NWAVES * 64, 2) fwd_kernel(Args args) {
    extern __shared__ __attribute__((aligned(16))) unsigned char lds_raw[];
    Frame F;
    F.lds = (LAS unsigned char*)lds_raw; F.ws = args.ws; F.out = args.out;
    F.tid = threadIdx.x; F.lane = F.tid & 63; F.wave = __builtin_amdgcn_readfirstlane(F.tid >> 6);
    F.G = gridDim.x; F.gw = blockIdx.x * NWAVES + F.wave; F.NGW = F.G * NWAVES;
    const int lo = args.ph_lo, hi = args.ph_hi;
#define IN(k) (lo <= (k) && (k) < hi)
    unsigned nbar = 0u; unsigned* gctr = (unsigned*)(args.ws + WS_CTL) + 128;
    volatile LAS unsigned* xst = (volatile LAS unsigned*)(F.lds + LDS_BYTES - 64);
    if (F.tid < 16) xst[F.tid] = 0u;
    __syncthreads();
    XcdBarrier xbar = xcd_barrier_post((unsigned*)(args.ws + WS_CTL) + 2048, xst);
#define SEAM(k) do { if (IN(k) && IN((k) + 1)) { if (args.coop == 1) { xcd_barrier(xbar); } else if (args.coop == 3) { nbar += (unsigned)F.G; sub_barrier(gctr, nbar); } else if (args.coop == 2) cg::this_grid().sync(); } } while (0)
    typedef pg8::bf16_t b16;
    if (IN(0)) { p0_prologue(F, args); } SEAM(0);
    if (IN(1)) {
        pg8::Gemm g{(const b16*)(F.ws + WS_XB), (const b16*)(F.ws + WS_WIN), M, N1A, D}; pg8::StaticOrder S; S.init(M, N1A, F.G, (int)blockIdx.x);
        pg8::EpiH16<0> E{(b16*)(F.ws + WS_HA), (b16*)(F.ws + WS_HB), (b16*)(F.ws + WS_HB), NA, NB, NB, NA, 1 << 30};
        pg8::gemm_phase<pg8::EpiH16<0>, pg8::StaticOrder, true, true>(F.lds, g, S, E);
    } SEAM(1);
    if (IN(2)) { p2a_prep(F, args); } SEAM(2);
    if (IN(3)) {
        pg8::Gemm g{(const b16*)((unsigned char*)F.out + OUT_AP), (const b16*)(F.ws + WS_WL), M, 3072, args.klora}; pg8::StaticOrder S; S.init(M, 3072, F.G, (int)blockIdx.x);
        pg8::EpiH16<2> E{(b16*)(F.ws + WS_LRW), (b16*)(F.ws + WS_LRA), (b16*)(F.ws + WS_G), DR, DR, DR, 1024, 2048};
        pg8::gemm_phase<pg8::EpiH16<2>, pg8::StaticOrder, true, true>(F.lds, g, S, E);
    } SEAM(3);
    if (IN(4)) { p2c_rwkv_prep(F, args); } SEAM(4);
    if (IN(5)) {
        if (blockIdx.x < 128) {
            const int i_ = (int)blockIdx.x, x_ = i_ & 7, j_ = i_ >> 3; rwkv_scan_unit(F, ((((j_ >> 2) << 3) + x_) << 2) | (j_ & 3)); }
        else {
            const int bb = (int)blockIdx.x - 128; unsigned* ctr = (unsigned*)(F.ws + WS_CTL) + 64;
            {
                pg8::Gemm g{(const b16*)(F.ws + WS_XB), (const b16*)(F.ws + WS_WIN) + (size_t)N1A * D, M, 6400 - N1A, D}; pg8::StaticOrder S; S.init(M, 6400 - N1A, 128, bb);
                pg8::EpiH16<0> E{(b16*)(F.ws + WS_HB) + (N1A - NA), (b16*)(F.ws + WS_HB), (b16*)(F.ws + WS_HB), NB, NB, NB, 1 << 30, 1 << 30};
                pg8::gemm_phase<pg8::EpiH16<0>, pg8::StaticOrder, true, true>(F.lds, g, S, E);
            }
            sub_barrier(ctr, 128u);
            ret_rotary(F, bb * NWAVES + F.wave, 128 * NWAVES);
            sub_barrier(ctr, 256u);
            for (int u = bb; u < 1024; u += 128) ret_transpose_unit(F, u);
            sub_barrier(ctr, 384u);
            if (bb < 64) ret_scan_unit(F, ((bb & 7) << 3) | (bb >> 3));
            else {
                p0_late_weights(F, args, (bb - 64) * NWAVES + F.wave, 64 * NWAVES);
                __syncthreads();
                pg8::Gemm g{(const b16*)(F.ws + WS_XB), (const b16*)(F.ws + WS_WIN) + (size_t)6400 * D, M, 1024, D}; pg8::StaticOrder S; S.init(M, 1024, 64, bb - 64);
                pg8::EpiH16<0> E{(b16*)(F.ws + WS_HB) + 3072, (b16*)(F.ws + WS_HB), (b16*)(F.ws + WS_HB), NB, NB, NB, 1 << 30, 1 << 30};
                pg8::gemm_phase<pg8::EpiH16<0>, pg8::StaticOrder, true, true>(F.lds, g, S, E);
            }
            sub_barrier(ctr, 512u);
        }
    }
    if (IN(5)) { if (blockIdx.x >= 128) { for (int u = (int)blockIdx.x - 128; u < 1024; u += 128) ret_intra_unit(F, args, u); } } SEAM(5);
    if (IN(6)) { rwkv_finalize(F, args); } SEAM(6);
    if (IN(7)) {
        pg8::Gemm g{(const b16*)(F.ws + WS_MIX), (const b16*)(F.ws + WS_WO), M, D, D}; pg8::StaticOrder S; S.init(M, D, F.G, (int)blockIdx.x);
        pg8::EpiH16<0> E{(b16*)(F.ws + WS_HB), (b16*)(F.ws + WS_HB), (b16*)(F.ws + WS_HB), D, D, D, 1 << 30, 1 << 30};
        pg8::gemm_phase<pg8::EpiH16<0>, pg8::StaticOrder, true, true>(F.lds, g, S, E);
    } SEAM(7);
    if (IN(8)) { ln_pass<false>(F, args.in[0], (const bf16*)(F.ws + WS_HB), nullptr, (bf16*)(F.ws + WS_X1B), args.in[15], args.in[16]); } SEAM(8);
    if (IN(9)) {
        pg8::Gemm g{(const b16*)(F.ws + WS_X1B), (const b16*)(F.ws + WS_WUP), M, DFF, D}; pg8::StaticOrder S; S.init(M, DFF, F.G, (int)blockIdx.x);
        pg8::EpiH16<1> E{(b16*)(F.ws + WS_U), (b16*)(F.ws + WS_U), (b16*)(F.ws + WS_U), DFF, DFF, DFF, 1 << 30, 1 << 30};
        pg8::gemm_phase<pg8::EpiH16<1>, pg8::StaticOrder, true, true>(F.lds, g, S, E);
    } SEAM(9);
    if (IN(10)) {
        pg8::Gemm g{(const b16*)(F.ws + WS_U), (const b16*)(F.ws + WS_WDN), M, D, DFF}; pg8::StaticOrder S; S.init(M, D, F.G, (int)blockIdx.x);
        pg8::EpiH16<0> E{(b16*)(F.ws + WS_KT), (b16*)(F.ws + WS_KT), (b16*)(F.ws + WS_KT), D, D, D, 1 << 30, 1 << 30};
        pg8::gemm_phase<pg8::EpiH16<0>, pg8::StaticOrder, true, true>(F.lds, g, S, E);
    } SEAM(10);
    if (IN(11)) { ln_pass<true>(F, (const bf16*)(F.ws + WS_X1B), (const bf16*)(F.ws + WS_KT), F.out, nullptr, args.in[19], args.in[20]); }
#undef IN
#undef SEAM
}

extern "C" void kernel_launch(void* const* d_in, const int* in_sizes, int n_in, void* d_out, int out_size, void* d_ws, size_t ws_size, hipStream_t stream) {
    static int grid = 0;
    if (grid == 0) {
        if (n_in != 21 || in_sizes[0] != M * D || out_size != M * D || ws_size < WS_END) { fprintf(stderr, "kernel_launch: unexpected shapes: n_in %d in0 %d out %d ws %zu\n", n_in, n_in > 0 ? in_sizes[0] : -1, out_size, ws_size); grid = -1; return; }
        int dev = 0, cus = 0;
        if (hipGetDevice(&dev) != hipSuccess || hipDeviceGetAttribute(&cus, hipDeviceAttributeMultiprocessorCount, dev) != hipSuccess) { grid = -1; return; }
        if (hipFuncSetAttribute((const void*)fwd_kernel, hipFuncAttributeMaxDynamicSharedMemorySize, LDS_BYTES) != hipSuccess) { fprintf(stderr, "kernel_launch: hipFuncSetAttribute failed\n"); grid = -1; return; }
        (void)hipGetLastError();
        if (cus < 256) { fprintf(stderr, "kernel_launch: this kernel splits phase 5 over exactly 256 co-resident workgroups; device has %d CUs\n", cus); grid = -1; return; }
        grid = 256;
    }
    if (grid < 0) return;
    (void)hipMemsetAsync(d_ws, 0, 32768, stream);
    Args a{};
    for (int i = 0; i < 21; ++i) a.in[i] = (const float*)d_in[i];
    a.out = (float*)d_out; a.ws = (unsigned char*)d_ws; a.klora = NLORA;
    a.ph_lo = 0; a.ph_hi = N_PHASES; a.coop = 1;
    void* kargs[] = {&a};
    hipError_t e = hipLaunchCooperativeKernel((const void*)fwd_kernel, dim3(grid), dim3(NWAVES * 64), kargs, LDS_BYTES, stream);
    if (e != hipSuccess) fprintf(stderr, "kernel_launch: cooperative launch failed: %s (grid %d)\n", hipGetErrorString(e), grid);
}
```
